# Optimizing an MI355X kernel written in HIP

```python
import math
import jax, jax.numpy as jnp
from jax import lax
import numpy as np

D_MODEL = 1024
BATCH = 8
SEQ = 8192
DEPTH = 2
DEC_BATCH = 32
DEC_SEQ = 64
PAST_LEN = 4096

CHUNK = 64
WIDTH_A = 512
WIDTH_B = 512
MIX_WIDTH = WIDTH_A + WIDTH_B
SSM_GROUP_CH = 16
SSM_GROUPS = WIDTH_A // SSM_GROUP_CH
SSM_STATE = 64
POOL_WINDOWS = (2, 4, 8, 16)
POOL_GROUPS = len(POOL_WINDOWS)
POOL_GROUP_CH = WIDTH_B // POOL_GROUPS
POOL_HIST = max(POOL_WINDOWS) - 1
D_FF = 4 * D_MODEL
RMS_EPS = 1e-5
DT_MIN = 1e-3
DT_MAX = 1e-1

kernel_name = "s5_pool_hybrid_stream_step"


def rmsnorm(x, g):
    xf = x.astype(jnp.float32)
    y = xf * lax.rsqrt(jnp.mean(xf * xf, axis=-1, keepdims=True) + RMS_EPS)
    return (y * g.astype(jnp.float32)).astype(x.dtype)


def _scan_op(e1, e2):
    a1, b1 = e1
    a2, b2 = e2
    return a1 * a2, a2 * b1 + b2


def s5_mixer(u, h0, lam_re, lam_im, log_dt, b_re, b_im, c_re, c_im, d, w_glu):
    bsz, L, _ = u.shape
    f32 = jnp.float32
    lam = lax.complex(lam_re.astype(f32), lam_im.astype(f32))
    dt = jnp.exp(log_dt.astype(f32))[:, None]
    lam_dt = lam * dt
    lam_bar = jnp.exp(lam_dt)
    b = lax.complex(b_re.astype(f32), b_im.astype(f32))
    b_bar = ((lam_bar - 1.0) / lam)[..., None] * b
    c = lax.complex(c_re.astype(f32), c_im.astype(f32))
    blk = min(L, CHUNK)
    nblk = L // blk
    ug = u.astype(f32).reshape(bsz, nblk, blk, SSM_GROUPS, SSM_GROUP_CH).transpose(1, 0, 2, 3, 4)
    lam_pow = jnp.exp(lam_dt[None] * jnp.arange(1, blk + 1, dtype=f32)[:, None, None])
    a_elems = jnp.broadcast_to(lam_bar, (bsz, blk, SSM_GROUPS, SSM_STATE))

    def step(h, u_blk):
        bu = jnp.einsum('btgc,gpc->btgp', u_blk.astype(jnp.complex64), b_bar)
        _, hs = lax.associative_scan(_scan_op, (a_elems, bu), axis=1)
        hs = hs + lam_pow[None] * h[:, None]
        y = jnp.einsum('gcp,btgp->btgc', c, hs).real
        return hs[:, -1], y

    h_last, ys = lax.scan(step, h0, ug)
    y = ys.transpose(1, 0, 2, 3, 4).reshape(bsz, L, WIDTH_A)
    y = y + d.astype(f32) * u.astype(f32)
    z = jax.nn.gelu(y)
    out = z * jax.nn.sigmoid(z @ w_glu.astype(f32))
    return out.astype(u.dtype), h_last


def pool_mixer(u, hist, start_pos, w_pool, scale):
    bsz, L, _ = u.shape
    full = jnp.concatenate([hist.astype(u.dtype), u], axis=1)
    ff = full.astype(jnp.float32)
    cs0 = jnp.concatenate([jnp.zeros((bsz, 1, WIDTH_B), jnp.float32), lax.cumsum(ff, axis=1)], axis=1)
    pos = jnp.arange(L) + start_pos
    groups = []
    for k, w in enumerate(POOL_WINDOWS):
        sl = slice(k * POOL_GROUP_CH, (k + 1) * POOL_GROUP_CH)
        wsum = cs0[:, POOL_HIST + 1:POOL_HIST + 1 + L, sl] - cs0[:, POOL_HIST + 1 - w:POOL_HIST + 1 - w + L, sl]
        cnt = jnp.minimum(pos + 1, w).astype(jnp.float32)[None, :, None]
        groups.append(wsum / cnt)
    pooled = jnp.stack(groups, axis=2)
    diff = pooled - u.astype(jnp.float32).reshape(bsz, L, POOL_GROUPS, POOL_GROUP_CH)
    y = jnp.einsum('blkc,kcd->blkd', diff, w_pool.astype(jnp.float32)).reshape(bsz, L, WIDTH_B)
    y = y * scale.astype(jnp.float32)
    new_hist = full[:, -POOL_HIST:]
    return y.astype(u.dtype), new_hist


def trunk_layer(x, h0, pool_hist, start_pos, g_mix, g_ffn, w_in, lam_re, lam_im, log_dt,
                b_re, b_im, c_re, c_im, d, w_glu, w_pool, pool_scale, w_out, w_ff1, w_ff2):
    hn = rmsnorm(x, g_mix)
    proj = hn @ w_in
    u_a = proj[..., :WIDTH_A]
    u_b = proj[..., WIDTH_A:]
    y_a, h_last = s5_mixer(u_a, h0, lam_re, lam_im, log_dt, b_re, b_im, c_re, c_im, d, w_glu)
    y_b, new_hist = pool_mixer(u_b, pool_hist, start_pos, w_pool, pool_scale)
    x = x + jnp.concatenate([y_a, y_b], axis=-1) @ w_out
    hf = rmsnorm(x, g_ffn)
    x = x + jnp.square(jax.nn.relu(hf @ w_ff1)) @ w_ff2
    return x, h_last, new_hist


def setup_inputs(seed: int = 0) -> dict:
    key = jax.random.key(seed)
    ks = jax.random.split(key, 24)
    f32 = jnp.float32
    nrm = lambda k, s, sc: jax.random.normal(k, s, f32) * sc
    n_idx = jnp.arange(SSM_STATE, dtype=f32)
    lam_re = -0.5 + 0.01 * jax.random.normal(ks[5], (DEPTH, SSM_GROUPS, SSM_STATE), f32)
    lam_im = math.pi * n_idx[None, None, :] + 0.01 * jax.random.normal(ks[6], (DEPTH, SSM_GROUPS, SSM_STATE), f32)
    log_dt = jax.random.uniform(ks[7], (DEPTH, SSM_GROUPS), f32, math.log(DT_MIN), math.log(DT_MAX))
    return {
        "x_prompt": nrm(ks[0], (BATCH, SEQ, D_MODEL), 1.0),
        "x_sample": nrm(ks[1], (DEC_BATCH, DEC_SEQ, D_MODEL), 1.0),
        "state_ssm_re": nrm(ks[2], (DEPTH, DEC_BATCH, SSM_GROUPS, SSM_STATE), 0.1),
        "state_ssm_im": nrm(ks[3], (DEPTH, DEC_BATCH, SSM_GROUPS, SSM_STATE), 0.1),
        "state_pool": nrm(ks[4], (DEPTH, DEC_BATCH, POOL_HIST, WIDTH_B), 1.0),
        "g_mix": 1.0 + nrm(ks[8], (DEPTH, D_MODEL), 0.02),
        "g_ffn": 1.0 + nrm(ks[9], (DEPTH, D_MODEL), 0.02),
        "w_in": nrm(ks[10], (DEPTH, D_MODEL, MIX_WIDTH), D_MODEL ** -0.5),
        "ssm_lambda_re": lam_re,
        "ssm_lambda_im": lam_im,
        "ssm_log_dt": log_dt,
        "ssm_b_re": nrm(ks[11], (DEPTH, SSM_GROUPS, SSM_STATE, SSM_GROUP_CH), (2 * SSM_GROUP_CH) ** -0.5),
        "ssm_b_im": nrm(ks[12], (DEPTH, SSM_GROUPS, SSM_STATE, SSM_GROUP_CH), (2 * SSM_GROUP_CH) ** -0.5),
        "ssm_c_re": nrm(ks[13], (DEPTH, SSM_GROUPS, SSM_GROUP_CH, SSM_STATE), (2 * SSM_STATE) ** -0.5),
        "ssm_c_im": nrm(ks[14], (DEPTH, SSM_GROUPS, SSM_GROUP_CH, SSM_STATE), (2 * SSM_STATE) ** -0.5),
        "ssm_d": nrm(ks[15], (DEPTH, WIDTH_A), 1.0),
        "w_glu": nrm(ks[16], (DEPTH, WIDTH_A, WIDTH_A), WIDTH_A ** -0.5),
        "w_pool": nrm(ks[17], (DEPTH, POOL_GROUPS, POOL_GROUP_CH, POOL_GROUP_CH), POOL_GROUP_CH ** -0.5),
        "pool_scale": 1.0 + nrm(ks[18], (DEPTH, WIDTH_B), 0.05),
        "w_out": nrm(ks[19], (DEPTH, MIX_WIDTH, D_MODEL), MIX_WIDTH ** -0.5),
        "w_ff1": nrm(ks[20], (DEPTH, D_MODEL, D_FF), D_MODEL ** -0.5),
        "w_ff2": nrm(ks[21], (DEPTH, D_FF, D_MODEL), D_FF ** -0.5),
        "g_final": 1.0 + nrm(ks[22], (D_MODEL,), 0.02),
    }


def reference(x_prompt, x_sample, state_ssm_re, state_ssm_im, state_pool, g_mix, g_ffn, w_in,
              ssm_lambda_re, ssm_lambda_im, ssm_log_dt, ssm_b_re, ssm_b_im, ssm_c_re, ssm_c_im,
              ssm_d, w_glu, w_pool, pool_scale, w_out, w_ff1, w_ff2, g_final):
    f32 = jnp.float32
    xp = x_prompt
    xs = x_sample
    p_re, p_im, p_pool, s_re, s_im, s_pool = [], [], [], [], [], []
    for l in range(DEPTH):
        lw = (g_mix[l], g_ffn[l], w_in[l], ssm_lambda_re[l], ssm_lambda_im[l], ssm_log_dt[l],
              ssm_b_re[l], ssm_b_im[l], ssm_c_re[l], ssm_c_im[l], ssm_d[l], w_glu[l], w_pool[l],
              pool_scale[l], w_out[l], w_ff1[l], w_ff2[l])
        h0_p = jnp.zeros((xp.shape[0], SSM_GROUPS, SSM_STATE), jnp.complex64)
        hist_p = jnp.zeros((xp.shape[0], POOL_HIST, WIDTH_B), xp.dtype)
        xp, hp_last, hist_p_new = trunk_layer(xp, h0_p, hist_p, 0, *lw)
        p_re.append(hp_last.real)
        p_im.append(hp_last.imag)
        p_pool.append(hist_p_new)
        h0_s = lax.complex(state_ssm_re[l].astype(f32), state_ssm_im[l].astype(f32))
        xs, hs_last, hist_s_new = trunk_layer(xs, h0_s, state_pool[l], PAST_LEN, *lw)
        s_re.append(hs_last.real)
        s_im.append(hs_last.imag)
        s_pool.append(hist_s_new)
    y_prompt = rmsnorm(xp, g_final)
    y_sample = rmsnorm(xs, g_final)
    new_p_ssm_re = jnp.stack(p_re, axis=0)
    new_p_ssm_im = jnp.stack(p_im, axis=0)
    new_p_pool = jnp.stack(p_pool, axis=0)
    new_s_ssm_re = jnp.stack(s_re, axis=0)
    new_s_ssm_im = jnp.stack(s_im, axis=0)
    new_s_pool = jnp.stack(s_pool, axis=0)
    return (y_prompt, y_sample, new_p_ssm_re, new_p_ssm_im, new_p_pool, new_s_ssm_re, new_s_ssm_im, new_s_pool)
```

```cpp
#include <hip/hip_runtime.h>
#include <hip/hip_cooperative_groups.h>
#include <cstdio>
#include <cstdint>
namespace cg = cooperative_groups;

#ifndef MK_PER_PHASE
#define MK_PER_PHASE 0
#endif

#define LAS __attribute__((address_space(3)))
typedef unsigned short bf16_t;
typedef short bf16x8 __attribute__((ext_vector_type(8)));
typedef float f32x4 __attribute__((ext_vector_type(4)));
typedef float f32x2 __attribute__((ext_vector_type(2)));
typedef unsigned u32x4 __attribute__((ext_vector_type(4)));
typedef unsigned u32x2 __attribute__((ext_vector_type(2)));

constexpr int DM = 1024, FF = 4096, WA = 512, WB = 512;
constexpr int PB_ = 8, PL = 8192, SB_ = 32, SL = 64;
constexpr int MP = PB_ * PL, MS = SB_ * SL, M = MP + MS;
constexpr int TS = 16;
constexpr int NJ = M / TS;
constexpr int NJP = 4352;
constexpr int ABP = 768;
constexpr int NG = 32, NP = 64;
constexpr float EPS = 1e-5f;
constexpr int NPH = 19;

constexpr size_t O_Y = 0;
constexpr size_t O_PRE = (size_t)M * DM;
constexpr size_t O_PIM = O_PRE + 2 * PB_ * NG * NP;
constexpr size_t O_PPOOL = O_PIM + 2 * PB_ * NG * NP;
constexpr size_t O_SRE = O_PPOOL + 2 * PB_ * 15 * WB;
constexpr size_t O_SIM = O_SRE + 2 * SB_ * NG * NP;
constexpr size_t O_SPOOL = O_SIM + 2 * SB_ * NG * NP;

constexpr size_t MiB = 1u << 20;
constexpr size_t WS_RSQ = 0;
constexpr size_t WS_AUX = 2 * MiB;
constexpr size_t WS_BAR = 3 * MiB;
constexpr size_t WS_W = 4 * MiB;
constexpr size_t WL_IN = 0, WL_GLU = 2 * MiB, WL_POOL = 2 * MiB + 512 * 1024, WL_OUT = 3 * MiB, WL_W1 = 5 * MiB, WL_W2 = 13 * MiB, WL_WE = 21 * MiB, WL_TY = 27 * MiB, WL_SZ = 33 * MiB;
constexpr size_t WS_XB = 72 * MiB;
constexpr size_t WS_H = 204 * MiB;
constexpr size_t WS_UB = WS_H;
constexpr size_t WS_AB = WS_H + 66 * MiB;
constexpr size_t WS_E = WS_H + 168 * MiB;
constexpr size_t WS_Z = WS_H + 234 * MiB;
constexpr size_t WS_DIFF = WS_H + 300 * MiB;
constexpr size_t WS_MIX = WS_H + 366 * MiB;
constexpr size_t WS_SLAB = WS_H + 528 * MiB;
constexpr size_t WS_END = WS_SLAB + 64 * MiB;
static_assert((size_t)16 * NJP * ABP * 2 <= 102 * MiB && (size_t)32 * NJ * 128 * 4 <= 66 * MiB && (size_t)M * 512 * 2 <= 66 * MiB, "ws map");

constexpr int LDS_BYTES = 147456;

namespace pg8 {
constexpr int BM = 256, BK = 64, HALF = 128, HTB = HALF * BK * 2, STAGE_BYTES = 8 * HTB, NXCD = 8, WGM = 8;

__host__ __device__ __forceinline__ int lds_byte(int r, int c) { const int st = (r >> 4) * 2 + (c >> 5), rr = r & 15, cc = c & 31, ob = rr * 64 + cc * 2; return st * 1024 + (ob ^ (((ob >> 9) & 1) << 5)); }
__host__ __device__ __forceinline__ void stage_rc(int b, int& R, int& C) { const int st = b / 1024, sb = b % 1024, swz = sb ^ (((sb >> 9) & 1) << 5); R = (st >> 1) * 16 + swz / 64; C = (st & 1) * 32 + (swz % 64) / 2; }
__host__ __device__ __forceinline__ int perm32(int rho) { const int n = rho >> 4, i = rho & 15; return 8 * (i >> 2) + 4 * n + (i & 3); }

struct Unit { int pm, pn, pz; };
struct Gemm { const bf16_t* A; const bf16_t* Bt; int lda, ldb, K, nM, nN, nZ, zs; size_t sAhi, sAlo, sB; };

struct StaticOrder {
    int nM, nMt, nN, nwg, G, c;
    __device__ __forceinline__ void init(const Gemm& g, int G_, int c_) { nM = g.nM; nMt = g.nM * g.nZ; nN = g.nN; nwg = nMt * nN; G = G_; c = c_; }
    __device__ __forceinline__ bool next(int i, Unit& u) const {
        const long L = (long)i * G + c; if (L >= nwg) return false;
        int wgid = (int)L; { const int q = nwg / NXCD, r = nwg % NXCD, xcd = wgid % NXCD, off = wgid / NXCD; wgid = (xcd < r ? xcd * (q + 1) : r * (q + 1) + (xcd - r) * q) + off; }
        const int nig = WGM * nN, gid = wgid / nig, fm = gid * WGM, gsz = (nMt - fm) < WGM ? (nMt - fm) : WGM;
        const int pmt = fm + ((wgid % nig) % gsz); u.pn = (wgid % nig) / gsz; u.pz = pmt / nM; u.pm = pmt - u.pz * nM; return true;
    }
};

__device__ __forceinline__ unsigned cvt_pk_bf16(float lo, float hi) { unsigned r; asm volatile("v_cvt_pk_bf16_f32 %0, %1, %2" : "=v"(r) : "v"(lo), "v"(hi)); return r; }
__device__ __forceinline__ float bf_lo(unsigned w) { return __uint_as_float(w << 16); }
__device__ __forceinline__ float bf_hi(unsigned w) { return __uint_as_float(w & 0xffff0000u); }
__device__ __forceinline__ u32x4 pack8(const f32x4 a, const f32x4 b) { u32x4 w; w.x = cvt_pk_bf16(a[0], a[1]); w.y = cvt_pk_bf16(a[2], a[3]); w.z = cvt_pk_bf16(b[0], b[1]); w.w = cvt_pk_bf16(b[2], b[3]); return w; }

#define EPI_ARGS const f32x4 (&acc)[2][2][4][2], const Unit& u, int wr, int wc, int fr, int fq

struct EpiIn {
    const float* rsq; bf16_t* AB; bf16_t* UB;
    __device__ __forceinline__ void operator()(EPI_ARGS) const {
        const int row0 = u.pm * BM + wr * 64 + fr, colt = u.pn * BM + wc * 32 + 8 * fq;
        float rs[2][4];
#pragma unroll
        for (int ai = 0; ai < 2; ++ai)
#pragma unroll
            for (int m = 0; m < 4; ++m) rs[ai][m] = rsq[row0 + ai * HALF + m * 16];
#pragma unroll
        for (int ai = 0; ai < 2; ++ai)
#pragma unroll
            for (int m = 0; m < 4; ++m) {
                const int row = row0 + ai * HALF + m * 16;
                const float r = __builtin_amdgcn_rsqf(rs[ai][m] * (1.0f / DM) + EPS);
#pragma unroll
                for (int bj = 0; bj < 2; ++bj) {
                    const int col = colt + bj * HALF;
                    const u32x4 w = pack8(acc[ai][bj][m][0] * r, acc[ai][bj][m][1] * r);
                    if (u.pn < 2) { const int g = col >> 4, c = col & 15; *(u32x4*)(AB + ((size_t)((g >> 1) * NJP + (row >> 4)) * ABP + (g & 1) * 384 + (row & 15) * 16 + c)) = w; }
                    else *(u32x4*)(UB + (size_t)row * WB + (col - WA)) = w;
                }
            }
    }
};
struct EpiE {
    bf16_t* E;
    __device__ __forceinline__ void operator()(EPI_ARGS) const {
        const int row0 = u.pm * BM + wr * 64 + fr, colt = wc * 32 + 8 * fq;
#pragma unroll
        for (int ai = 0; ai < 2; ++ai)
#pragma unroll
            for (int m = 0; m < 4; ++m) {
                const int j = row0 + ai * HALF + m * 16;
                if (j < NJ) {
#pragma unroll
                    for (int bj = 0; bj < 2; ++bj)
                        *(u32x4*)(E + ((size_t)(2 * u.pz + bj) * NJ + j) * 128 + colt) = pack8(acc[ai][bj][m][0], acc[ai][bj][m][1]);
                }
            }
    }
};
template <int JB> struct EpiY {
    static constexpr bool A_TILED = false;
    const bf16_t* AB; const float* dvec; bf16_t* Z;
    __device__ __forceinline__ void operator()(EPI_ARGS) const {
        const int g = u.pz; const int row0 = JB + u.pm * BM + wr * 64 + fr, colt = wc * 32 + 8 * fq;
#pragma unroll
        for (int bj = 0; bj < 2; ++bj) {
            const int n = colt + bj * HALF, t = n >> 4, c = n & 15;
            const f32x4 d0 = *(const f32x4*)(dvec + g * 16 + c), d1 = *(const f32x4*)(dvec + g * 16 + c + 4);
#pragma unroll
            for (int ai = 0; ai < 2; ++ai) {
                u32x4 uw[4];
#pragma unroll
                for (int m = 0; m < 4; ++m) { const int j = row0 + ai * HALF + m * 16;
                    uw[m] = (j < NJ) ? *(const u32x4*)(AB + ((size_t)((g >> 1) * NJP + j) * ABP + (g & 1) * 384 + n)) : (u32x4){0u, 0u, 0u, 0u}; }
#pragma unroll
                for (int m = 0; m < 4; ++m) { const int j = row0 + ai * HALF + m * 16;
                    if (j < NJ) {
                        const u32x4 w = uw[m];
                        f32x4 u0 = {bf_lo(w.x), bf_hi(w.x), bf_lo(w.y), bf_hi(w.y)}, u1 = {bf_lo(w.z), bf_hi(w.z), bf_lo(w.w), bf_hi(w.w)};
                        f32x4 y0 = acc[ai][bj][m][0] + d0 * u0, y1 = acc[ai][bj][m][1] + d1 * u1;
#pragma unroll
                        for (int e = 0; e < 4; ++e) {
                            { const float y = y0[e], q = 1.5957691216f * (y + 0.044715f * y * y * y); y0[e] = y * __builtin_amdgcn_rcpf(1.0f + __expf(-q)); }
                            { const float y = y1[e], q = 1.5957691216f * (y + 0.044715f * y * y * y); y1[e] = y * __builtin_amdgcn_rcpf(1.0f + __expf(-q)); }
                        }
                        *(u32x4*)(Z + (size_t)(j * TS + t) * WA + g * 16 + c) = pack8(y0, y1);
                    }
                }
            }
        }
    }
};
struct EpiGlu {
    const bf16_t* Z; bf16_t* MIX;
    __device__ __forceinline__ void operator()(EPI_ARGS) const {
        const int row0 = u.pm * BM + wr * 64 + fr, colt = u.pn * BM + wc * 32 + 8 * fq;
#pragma unroll
        for (int ai = 0; ai < 2; ++ai) {
            u32x4 zw[4][2];
#pragma unroll
            for (int m = 0; m < 4; ++m)
#pragma unroll
                for (int bj = 0; bj < 2; ++bj) zw[m][bj] = *(const u32x4*)(Z + (size_t)(row0 + ai * HALF + m * 16) * WA + colt + bj * HALF);
#pragma unroll
            for (int m = 0; m < 4; ++m) {
                const int row = row0 + ai * HALF + m * 16;
#pragma unroll
                for (int bj = 0; bj < 2; ++bj) {
                    f32x4 a0 = acc[ai][bj][m][0], a1 = acc[ai][bj][m][1];
                    const u32x4 w = zw[m][bj];
                    const f32x4 z0 = {bf_lo(w.x), bf_hi(w.x), bf_lo(w.y), bf_hi(w.y)}, z1 = {bf_lo(w.z), bf_hi(w.z), bf_lo(w.w), bf_hi(w.w)};
#pragma unroll
                    for (int e = 0; e < 4; ++e) { a0[e] = z0[e] * __builtin_amdgcn_rcpf(1.0f + __expf(-a0[e])); a1[e] = z1[e] * __builtin_amdgcn_rcpf(1.0f + __expf(-a1[e])); }
                    *(u32x4*)(MIX + (size_t)row * DM + colt + bj * HALF) = pack8(a0, a1);
                }
            }
        }
    }
};
template <bool SC> struct EpiRes {
    bf16_t* XB; float* rsq; const float* rsc;
    __device__ __forceinline__ void operator()(EPI_ARGS) const {
        const int row0 = u.pm * BM + wr * 64 + fr, colt = u.pn * BM + wc * 32 + 8 * fq;
        float ssum[2][4];
#pragma unroll
        for (int ai = 0; ai < 2; ++ai) {
            u32x4 xw[4][2]; float sc[4];
#pragma unroll
            for (int m = 0; m < 4; ++m) {
                sc[m] = SC ? rsc[row0 + ai * HALF + m * 16] : 0.f;
#pragma unroll
                for (int bj = 0; bj < 2; ++bj) xw[m][bj] = *(const u32x4*)(XB + (size_t)(row0 + ai * HALF + m * 16) * DM + colt + bj * HALF);
            }
#pragma unroll
            for (int m = 0; m < 4; ++m) {
                const int row = row0 + ai * HALF + m * 16;
                const float r2 = SC ? __builtin_amdgcn_rcpf(sc[m] * (1.0f / DM) + EPS) : 1.0f;
                float ss = 0.f;
#pragma unroll
                for (int bj = 0; bj < 2; ++bj) {
                    const u32x4 w = xw[m][bj];
                    const f32x4 x0 = (f32x4){bf_lo(w.x), bf_hi(w.x), bf_lo(w.y), bf_hi(w.y)} + acc[ai][bj][m][0] * r2, x1 = (f32x4){bf_lo(w.z), bf_hi(w.z), bf_lo(w.w), bf_hi(w.w)} + acc[ai][bj][m][1] * r2;
                    *(u32x4*)(XB + (size_t)row * DM + colt + bj * HALF) = pack8(x0, x1);
                    ss += (x0[0] * x0[0] + x0[1] * x0[1]) + (x0[2] * x0[2] + x0[3] * x0[3]) + (x1[0] * x1[0] + x1[1] * x1[1]) + (x1[2] * x1[2] + x1[3] * x1[3]);
                }
                ss += __shfl_xor(ss, 16); ss += __shfl_xor(ss, 32);
                ssum[ai][m] = ss;
            }
        }
        const float s0 = fq == 0 ? ssum[0][0] : fq == 1 ? ssum[0][2] : fq == 2 ? ssum[1][0] : ssum[1][2];
        const float s1 = fq == 0 ? ssum[0][1] : fq == 1 ? ssum[0][3] : fq == 2 ? ssum[1][1] : ssum[1][3];
        const int k0 = 2 * fq, k1 = 2 * fq + 1;
        atomicAdd(rsq + row0 + (k0 >> 2) * HALF + (k0 & 3) * 16, s0);
        atomicAdd(rsq + row0 + (k1 >> 2) * HALF + (k1 & 3) * 16, s1);
    }
};
struct EpiSlab {
    float* S;
    __device__ __forceinline__ void operator()(EPI_ARGS) const {
        const int row0 = u.pm * BM + wr * 64 + fr, colt = u.pn * BM + wc * 32 + 8 * fq;
#pragma unroll
        for (int ai = 0; ai < 2; ++ai)
#pragma unroll
            for (int m = 0; m < 4; ++m)
#pragma unroll
                for (int bj = 0; bj < 2; ++bj) { float* dst = S + ((size_t)u.pz * MS + row0 + ai * HALF + m * 16) * DM + colt + bj * HALF;
                    *(f32x4*)dst = acc[ai][bj][m][0]; *(f32x4*)(dst + 4) = acc[ai][bj][m][1]; }
    }
};
struct EpiFF1 {
    bf16_t* H;
    __device__ __forceinline__ void operator()(EPI_ARGS) const {
        const int row0 = u.pm * BM + wr * 64 + fr, colt = u.pn * BM + wc * 32 + 8 * fq;
#pragma unroll
        for (int ai = 0; ai < 2; ++ai)
#pragma unroll
            for (int m = 0; m < 4; ++m) {
                const int row = row0 + ai * HALF + m * 16;
#pragma unroll
                for (int bj = 0; bj < 2; ++bj) {
                    f32x4 a0 = acc[ai][bj][m][0], a1 = acc[ai][bj][m][1];
#pragma unroll
                    for (int e = 0; e < 4; ++e) { const float p = fmaxf(a0[e], 0.f), q = fmaxf(a1[e], 0.f); a0[e] = p * p; a1[e] = q * q; }
                    __builtin_nontemporal_store(pack8(a0, a1), (u32x4*)(H + (size_t)row * FF + colt + bj * HALF));
                }
            }
    }
};

template <class Epi>
__device__ __forceinline__ void gemm_phase(LAS unsigned char* lds, const Gemm g, const int G, const int cidx, const int tid, const Epi& E) {
    const int wid = __builtin_amdgcn_readfirstlane(tid >> 6), lane = tid & 63, wr = wid >> 2, wc = wid & 3, fr = lane & 15, fq = lane >> 4;
    const int K = g.K, nt = K / BK;
    StaticOrder S; S.init(g, G, cidx);
    unsigned voffA[2], voffB[2];
#pragma unroll
    for (int i = 0; i < 2; ++i) { int R, C; stage_rc(tid * 16 + i * 8192, R, C); const int Rb = (R & ~31) + perm32(R & 31);
        voffA[i] = (unsigned)(R * g.lda + C) * 2u; voffB[i] = (unsigned)(Rb * g.ldb + C) * 2u; }
    const size_t kstep = (size_t)(BK * 2);
    const size_t hstepA = (size_t)HALF * g.lda * 2, hstepB = (size_t)HALF * g.ldb * 2;
    const size_t tstepA = 2 * hstepA, tstepB = 2 * hstepB;
    const unsigned ldsw = (unsigned)wid * 1024u;
    const int aoff = lds_byte(wr * 64 + fr, fq * 8), boff = lds_byte(wc * 32 + fr, fq * 8);
    const int zmask = (1 << g.zs) - 1;
#define PG8_SA(b, h) (((b) * 2 + (h)) * HTB)
#define PG8_SB(b, h) ((4 + (b) * 2 + (h)) * HTB)
#define PG8_STAGE(bufoff, gbase, voff) do { _Pragma("unroll") for (int _i = 0; _i < 2; ++_i) \
        __builtin_amdgcn_global_load_lds((const unsigned*)((const char*)(gbase) + (voff)[_i]), (LAS unsigned*)(lds + (bufoff) + ldsw + _i * 8192), 16, 0, 0); } while (0)
#define PG8_LDA(dst, b, h) do { _Pragma("unroll") for (int m = 0; m < 4; ++m) _Pragma("unroll") for (int k = 0; k < 2; ++k) dst[m][k] = *(const LAS bf16x8*)(lds + PG8_SA(b, h) + aoff + m * 2048 + k * 1024); } while (0)
#define PG8_LDB(dst, b, h) do { _Pragma("unroll") for (int n = 0; n < 2; ++n) _Pragma("unroll") for (int k = 0; k < 2; ++k) dst[n][k] = *(const LAS bf16x8*)(lds + PG8_SB(b, h) + boff + n * 2048 + k * 1024); } while (0)
#define PG8_MMA(ai, bj, At, Bt) do { __builtin_amdgcn_s_setprio(1); _Pragma("unroll") for (int m = 0; m < 4; ++m) _Pragma("unroll") for (int n = 0; n < 2; ++n) _Pragma("unroll") for (int k = 0; k < 2; ++k) \
        acc[ai][bj][m][n] = __builtin_amdgcn_mfma_f32_16x16x32_bf16(Bt[n][k], At[m][k], acc[ai][bj][m][n], 0, 0, 0); __builtin_amdgcn_s_setprio(0); } while (0)
#define PG8_WAIT_V(n) asm volatile("s_waitcnt vmcnt(" #n ")" ::: "memory")
#define PG8_WAIT_L(n) asm volatile("s_waitcnt lgkmcnt(" #n ")" ::: "memory")
#define PG8_BAR __builtin_amdgcn_s_barrier()
#define PG8_SCHED __builtin_amdgcn_sched_barrier(0)
#define PG8_ABASE(uu) ((const char*)g.A + (size_t)((uu).pz >> g.zs) * g.sAhi + (size_t)((uu).pz & zmask) * g.sAlo + (size_t)(uu).pm * tstepA)
#define PG8_BBASE(uu) ((const char*)g.Bt + (size_t)(uu).pz * g.sB + (size_t)(uu).pn * tstepB)
    Unit cur, nxt; int ui = 0;
    if (!S.next(0, cur)) return;
    f32x4 acc[2][2][4][2];
#pragma unroll
    for (int a = 0; a < 2; ++a)
#pragma unroll
        for (int b = 0; b < 2; ++b)
#pragma unroll
            for (int m = 0; m < 4; ++m)
#pragma unroll
                for (int n = 0; n < 2; ++n) acc[a][b][m][n] = (f32x4){0.f, 0.f, 0.f, 0.f};
    bf16x8 At[4][2], B0[2][2], B1[2][2];
    const char* cA = PG8_ABASE(cur); const char* cB = PG8_BBASE(cur);
    PG8_STAGE(PG8_SB(0, 0), cB, voffB); PG8_STAGE(PG8_SB(0, 1), cB + hstepB, voffB); PG8_STAGE(PG8_SA(0, 0), cA, voffA); PG8_STAGE(PG8_SA(0, 1), cA + hstepA, voffA);
    if (wr == 1) PG8_BAR;
    PG8_WAIT_V(2); PG8_BAR;
    PG8_STAGE(PG8_SB(1, 0), cB + kstep, voffB); PG8_STAGE(PG8_SA(1, 0), cA + kstep, voffA); PG8_STAGE(PG8_SB(1, 1), cB + hstepB + kstep, voffB);
    PG8_WAIT_V(6); PG8_BAR;
    for (;;) {
        const bool has_next = S.next(ui + 1, nxt);
        const char* nA = has_next ? PG8_ABASE(nxt) : cA; const char* nB = has_next ? PG8_BBASE(nxt) : cB;
        for (int t = 0; t < nt; t += 2) {
            const bool last = (t == nt - 2);
            const char* a1 = cA + (size_t)(t + 1) * kstep;
            const char* a2 = last ? nA : cA + (size_t)(t + 2) * kstep; const char* b2 = last ? nB : cB + (size_t)(t + 2) * kstep;
            const char* a3 = a2 + kstep; const char* b3 = b2 + kstep;
            PG8_LDB(B0, 0, 0); PG8_LDB(B1, 0, 1); PG8_SCHED; PG8_LDA(At, 0, 0); PG8_STAGE(PG8_SA(1, 1), a1 + hstepA, voffA);
            PG8_WAIT_V(8); PG8_WAIT_L(0); PG8_BAR; PG8_MMA(0, 0, At, B0); PG8_MMA(0, 1, At, B1); PG8_BAR; PG8_SCHED;
            PG8_LDA(At, 0, 1); PG8_STAGE(PG8_SB(0, 0), b2, voffB); PG8_STAGE(PG8_SB(0, 1), b2 + hstepB, voffB); PG8_STAGE(PG8_SA(0, 0), a2, voffA);
            PG8_WAIT_V(8); PG8_WAIT_L(0); PG8_BAR; PG8_MMA(1, 0, At, B0); PG8_MMA(1, 1, At, B1); PG8_BAR; PG8_SCHED;
            PG8_LDB(B0, 1, 0); PG8_LDB(B1, 1, 1); PG8_SCHED; PG8_LDA(At, 1, 0); PG8_STAGE(PG8_SA(0, 1), a2 + hstepA, voffA);
            PG8_WAIT_V(8); PG8_WAIT_L(0); PG8_BAR; PG8_MMA(0, 0, At, B0); PG8_MMA(0, 1, At, B1); PG8_BAR; PG8_SCHED;
            PG8_LDA(At, 1, 1); PG8_STAGE(PG8_SB(1, 0), b3, voffB); PG8_STAGE(PG8_SB(1, 1), b3 + hstepB, voffB); PG8_STAGE(PG8_SA(1, 0), a3, voffA);
            PG8_WAIT_V(8); PG8_WAIT_L(0); PG8_BAR; PG8_MMA(1, 0, At, B0); PG8_MMA(1, 1, At, B1); PG8_BAR; PG8_SCHED;
        }
        if (wr == 0) PG8_BAR;
        { int fr_ = fr, fq_ = fq; asm volatile("" : "+v"(fr_), "+v"(fq_));
          E(acc, cur, wr, wc, fr_, fq_); }
        if (!has_next) break;
#pragma unroll
        for (int a = 0; a < 2; ++a)
#pragma unroll
            for (int b = 0; b < 2; ++b)
#pragma unroll
                for (int m = 0; m < 4; ++m)
#pragma unroll
                    for (int n = 0; n < 2; ++n) acc[a][b][m][n] = (f32x4){0.f, 0.f, 0.f, 0.f};
        cur = nxt; cA = nA; cB = nB; ++ui;
        if (wr == 1) PG8_BAR;
    }
    PG8_WAIT_V(0);
    PG8_BAR;
#undef PG8_SA
#undef PG8_SB
#undef PG8_STAGE
#undef PG8_LDA
#undef PG8_LDB
#undef PG8_MMA
#undef PG8_WAIT_V
#undef PG8_WAIT_L
#undef PG8_BAR
#undef PG8_SCHED
#undef PG8_ABASE
#undef PG8_BBASE
}
}

__device__ __forceinline__ float wave_sum(float v) {
#pragma unroll
    for (int o = 1; o < 64; o <<= 1) v += __shfl_xor(v, o);
    return v;
}
__device__ __forceinline__ unsigned pk2(float lo, float hi) { return pg8::cvt_pk_bf16(lo, hi); }
__device__ __forceinline__ f32x2 cmul(f32x2 a, f32x2 b) { return (f32x2){a.x * b.x - a.y * b.y, a.x * b.y + a.y * b.x}; }

struct Args { const float* in[23]; float* out; unsigned char* ws; int ph_lo, ph_hi; };

__device__ __forceinline__ void transpose_item(const float* W, const float* gk, int K, int N, bf16_t* WT, LAS float* scr, int item, int lane) {
    const int nblk = N / 32, kb = item / nblk, nb = item % nblk, k0 = 64 * kb, n0 = 32 * nb;
#pragma unroll 8
    for (int i = 0; i < 32; ++i) { const int kk = 2 * i + (lane >> 5); float v = __builtin_nontemporal_load(W + (size_t)(k0 + kk) * N + n0 + (lane & 31));   if (gk) v *= gk[k0 + kk]; scr[kk * 33 + (lane & 31)] = v; }
    asm volatile("s_waitcnt lgkmcnt(0)" ::: "memory");
    const int c = lane & 7;
#pragma unroll
    for (int j = 0; j < 4; ++j) { const int n = (lane >> 3) + 8 * j; const LAS float* s = scr + (8 * c) * 33 + n;
        u32x4 o; o.x = pk2(s[0 * 33], s[1 * 33]); o.y = pk2(s[2 * 33], s[3 * 33]); o.z = pk2(s[4 * 33], s[5 * 33]); o.w = pk2(s[6 * 33], s[7 * 33]);
        *(u32x4*)(WT + (size_t)(n0 + n) * K + k0 + 8 * c) = o; }
    asm volatile("s_waitcnt lgkmcnt(0)" ::: "memory");
}

__device__ __forceinline__ void ssm_tables(const Args& a, LAS unsigned char* lds, int l, int g, const int tid) {
    LAS f32x2* sB = (LAS f32x2*)lds;
    LAS f32x2* sC = (LAS f32x2*)(lds + 8192);
    LAS f32x2* sP = (LAS f32x2*)(lds + 16384);
    LAS float* sK = (LAS float*)(lds + 25600);
    const float dt = expf(a.in[10][l * NG + g]);
    const float* lre = a.in[8] + (size_t)(l * NG + g) * NP; const float* lim = a.in[9] + (size_t)(l * NG + g) * NP;
    for (int idx = tid; idx < 17 * 64; idx += 512) { const int tau = idx >> 6, p = idx & 63; const float ar = lre[p] * dt * (float)tau, ai = lim[p] * dt * (float)tau;
        float sn, cs; sincosf(ai, &sn, &cs); const float ex = expf(ar); sP[idx] = (f32x2){ex * cs, ex * sn}; }
    for (int idx = tid; idx < 1024; idx += 512) { const int p = idx >> 4, c = idx & 15; const float ar = lre[p] * dt, ai = lim[p] * dt;
        float sn, cs; sincosf(ai, &sn, &cs); const float sh = sinf(0.5f * ai); const float em1 = expm1f(ar), ex = em1 + 1.0f;
        const float x = em1 * cs - 2.0f * sh * sh, y = ex * sn;
        const float ur = lre[p], ui = lim[p], den = 1.0f / (ur * ur + ui * ui);
        const f32x2 coef = {(x * ur + y * ui) * den, (y * ur - x * ui) * den};
        const size_t bo = ((size_t)(l * NG + g) * NP + p) * 16 + c;
        sB[idx] = cmul(coef, (f32x2){a.in[11][bo], a.in[12][bo]}); }
    for (int idx = tid; idx < 1024; idx += 512) { const size_t co = (size_t)(l * NG + g) * 1024 + idx; sC[idx] = (f32x2){a.in[13][co], a.in[14][co]}; }
    __syncthreads();
    for (int idx = tid; idx < 4096; idx += 512) { const int tau = idx >> 8, c = (idx >> 4) & 15, c2 = idx & 15; float s = 0.f;
        for (int p = 0; p < 64; ++p) { const f32x2 w = cmul(sC[c * 64 + p], sP[tau * 64 + p]); const f32x2 b = sB[p * 16 + c2]; s += w.x * b.x - w.y * b.y; }
        sK[idx] = s; }
    if (tid < 64) {
        f32x2* aux = (f32x2*)(a.ws + WS_AUX); f32x2 v = sP[16 * 64 + tid]; aux[(l * NG + g) * NP + tid] = v;
#pragma unroll
        for (int i = 0; i < 6; ++i) v = cmul(v, v);
        aux[2 * NG * NP + (l * NG + g) * NP + tid] = v;
    }
    __syncthreads();
    bf16_t* Ty = (bf16_t*)(a.ws + WS_W + (size_t)l * WL_SZ + WL_TY) + (size_t)g * 256 * 384;
    for (int v = tid; v < 256 * 48; v += 512) { const int row = v / 48, k0 = (v % 48) * 8, t = row >> 4, c = row & 15; float o[8];
        if (k0 < 256) { const int s = k0 >> 4, c0 = k0 & 15;
#pragma unroll
            for (int e = 0; e < 8; ++e) o[e] = (s <= t) ? sK[((t - s) * 16 + c) * 16 + c0 + e] : 0.f;
        } else { const int kk = k0 - 256;
#pragma unroll
            for (int e = 0; e < 8; ++e) { const int p = (kk + e) >> 1; const f32x2 w = cmul(sC[c * 64 + p], sP[(t + 1) * 64 + p]); o[e] = (e & 1) ? -w.y : w.x; }
        }
        u32x4 w; w.x = pk2(o[0], o[1]); w.y = pk2(o[2], o[3]); w.z = pk2(o[4], o[5]); w.w = pk2(o[6], o[7]);
        *(u32x4*)(Ty + (size_t)row * 384 + k0) = w; }
    const int gi = g & 1;
    bf16_t* We = (bf16_t*)(a.ws + WS_W + (size_t)l * WL_SZ + WL_WE) + ((size_t)(g >> 1) * 256 + gi * 128) * ABP;
    for (int v = tid; v < 128 * 96; v += 512) { const int rr = v / 96, k0 = (v % 96) * 8, p = rr >> 1, ri = rr & 1; float o[8];
        const int kq = k0 - gi * 384;
        if (kq >= 0 && kq < 256) { const int s = kq >> 4, c0 = kq & 15;
#pragma unroll
            for (int e = 0; e < 8; ++e) { const f32x2 w = cmul(sP[(15 - s) * 64 + p], sB[p * 16 + c0 + e]); o[e] = ri ? w.y : w.x; }
        } else {
#pragma unroll
            for (int e = 0; e < 8; ++e) o[e] = 0.f;
        }
        u32x4 w; w.x = pk2(o[0], o[1]); w.y = pk2(o[2], o[3]); w.z = pk2(o[4], o[5]); w.w = pk2(o[6], o[7]);
        *(u32x4*)(We + (size_t)rr * ABP + k0) = w; }
    __syncthreads();
}

__device__ __forceinline__ void wcomb_item(const Args& a, LAS unsigned char* lds, int l, int kg, int ntile, const int tid) {
    LAS float* sAt = (LAS float*)lds;
    LAS float* sBm = (LAS float*)(lds + 128 * 132 * 4);
    const float* wp = a.in[17] + (size_t)(l * 4 + kg) * 128 * 128; const float* sc = a.in[18] + l * WB + kg * 128;
    for (int idx = tid; idx < 16384; idx += 512) { const int c = idx >> 7, d = idx & 127; sAt[d * 132 + c] = wp[idx] * sc[d]; }
    const float* wo = a.in[19] + (size_t)l * DM * DM + (size_t)(512 + kg * 128) * DM + ntile * 64;
    for (int idx = tid; idx < 8192; idx += 512) { const int d = idx >> 6, n = idx & 63; sBm[idx] = wo[(size_t)d * DM + n]; }
    __syncthreads();
    const int n = tid >> 3, cs = (tid & 7) * 16;
    f32x4 acc0 = {0.f, 0.f, 0.f, 0.f}, acc1 = acc0, acc2 = acc0, acc3 = acc0;
    for (int d = 0; d < 128; ++d) { const float b = sBm[d * 64 + n]; const LAS f32x4* ap = (const LAS f32x4*)(sAt + d * 132 + cs);
        acc0 += ap[0] * b; acc1 += ap[1] * b; acc2 += ap[2] * b; acc3 += ap[3] * b; }
    bf16_t* dst = (bf16_t*)(a.ws + WS_W + (size_t)l * WL_SZ + WL_OUT) + (size_t)(ntile * 64 + n) * DM + 512 + kg * 128 + cs;
    *(u32x4*)dst = pg8::pack8(acc0, acc1); *(u32x4*)(dst + 8) = pg8::pack8(acc2, acc3);
    __syncthreads();
}

__device__ __forceinline__ void phase_prologue(const Args& a, LAS unsigned char* lds, int G, const int bid, const int tid) {
    const int lane = tid & 63, wave = tid >> 6;
    const int gw = bid * 8 + wave, NGW = G * 8;
    LAS float* scr = (LAS float*)(lds + wave * 16384);
    for (int it = gw; it < 16 * 32; it += NGW) transpose_item(a.in[7], a.in[5], DM, DM, (bf16_t*)(a.ws + WS_W + WL_IN), scr, it, lane);
    const int gt = bid * 512 + tid, NGT = G * 512;
    float* rsq = (float*)(a.ws + WS_RSQ);
    for (int i = gt; i < 4 * M; i += NGT) rsq[M + i] = 0.f;
    bf16_t* XB = (bf16_t*)(a.ws + WS_XB);
    for (int q = gw; q < M / 4; q += NGW) {
        f32x4 v[4][4];
#pragma unroll
        for (int rr = 0; rr < 4; ++rr) { const int m = 4 * q + rr; const float* src = m < MP ? a.in[0] + (size_t)m * DM : a.in[1] + (size_t)(m - MP) * DM;
#pragma unroll
            for (int j = 0; j < 4; ++j) v[rr][j] = __builtin_nontemporal_load(((const f32x4*)src) + lane + 64 * j); }
#pragma unroll
        for (int rr = 0; rr < 4; ++rr) { const int m = 4 * q + rr; float s = 0.f;
#pragma unroll
            for (int j = 0; j < 4; ++j) s += (v[rr][j].x * v[rr][j].x + v[rr][j].y * v[rr][j].y) + (v[rr][j].z * v[rr][j].z + v[rr][j].w * v[rr][j].w);
            s = wave_sum(s);
#pragma unroll
            for (int j = 0; j < 4; ++j) ((u32x2*)(XB + (size_t)m * DM))[lane + 64 * j] = (u32x2){pk2(v[rr][j].x, v[rr][j].y), pk2(v[rr][j].z, v[rr][j].w)};
            if (lane == 0) rsq[m] = s; }
    }
}
__device__ __forceinline__ void phase_prologue_rest(const Args& a, LAS unsigned char* lds, int G, const int bid, const int tid) {
    const int lane = tid & 63, wave = tid >> 6;
    const int nlead = (G == 256) ? 32 : 0;
    if (bid < nlead) return;
    const int vb = bid - nlead, GB = G - nlead;
    for (int item = vb; item < 2 * NG; item += GB) ssm_tables(a, lds, item / NG, item % NG, tid);
    for (int item = (vb + GB - 64 % GB) % GB; item < 2 * 4 * 16; item += GB) wcomb_item(a, lds, item >> 6, (item >> 4) & 3, item & 15, tid);
    const int ntab = (GB >= 128) ? 64 : 0;
    if (vb < ntab) return;
    const int gw = (vb - ntab) * 8 + wave, NGW = (GB - ntab) * 8;
    LAS float* scr = (LAS float*)(lds + wave * 16384);
    constexpr int I_IN = 16 * 32, I_GLU = 8 * 16, I_OUT = 8 * 32, I_1 = 16 * 128, I_2 = 64 * 32, I_L = I_IN + I_GLU + I_OUT + I_1 + I_2;
    for (int it = gw + I_IN; it < 2 * I_L; it += NGW) {
        const int l = it / I_L; int r = it - l * I_L; unsigned char* wl = a.ws + WS_W + (size_t)l * WL_SZ;
        if (r < I_IN) { transpose_item(a.in[7] + (size_t)l * DM * DM, a.in[5] + l * DM, DM, DM, (bf16_t*)(wl + WL_IN), scr, r, lane); continue; } r -= I_IN;
        if (r < I_GLU) { transpose_item(a.in[16] + (size_t)l * WA * WA, nullptr, WA, WA, (bf16_t*)(wl + WL_GLU), scr, r, lane); continue; } r -= I_GLU;
        if (r < I_OUT) { transpose_item(a.in[19] + (size_t)l * DM * DM, nullptr, DM, DM, (bf16_t*)(wl + WL_OUT), scr, r, lane); continue; } r -= I_OUT;
        if (r < I_1) { transpose_item(a.in[20] + (size_t)l * DM * FF, a.in[6] + l * DM, DM, FF, (bf16_t*)(wl + WL_W1), scr, r, lane); continue; } r -= I_1;
        transpose_item(a.in[21] + (size_t)l * FF * DM, nullptr, FF, DM, (bf16_t*)(wl + WL_W2), scr, r, lane);
    }
}

__device__ __forceinline__ void phase_diff(const Args& a, int l, int G, const int bid, const int tid) {
    const int lane = tid & 63, wave = tid >> 6;
    const int nskip = (G == 256) ? 16 : 0;
    if (bid < nskip) return;
    const int gw = (bid - nskip) * 8 + wave, NGW = (G - nskip) * 8;
    const bf16_t* UB = (const bf16_t*)(a.ws + WS_UB); bf16_t* MIXB = (bf16_t*)(a.ws + WS_MIX) + WA;
    const int n0 = lane * 8, w = 2 << (lane >> 4);
    for (int r = gw; r < M / 32; r += NGW) {
        const int m0 = r * 32; const bool prm = m0 < MP;
        int seq, t0, L, mseq; const float* hist; float* hout;
        if (prm) { seq = m0 / PL; t0 = m0 % PL; L = PL; mseq = seq * PL; hist = nullptr; hout = a.out + O_PPOOL + (size_t)(l * PB_ + seq) * 15 * WB; }
        else { const int ms = m0 - MP; seq = ms / SL; t0 = ms % SL; L = SL; mseq = MP + seq * SL; hist = a.in[4] + (size_t)(l * SB_ + seq) * 15 * WB; hout = a.out + O_SPOOL + (size_t)(l * SB_ + seq) * 15 * WB; }
        float ws_[8];
#pragma unroll
        for (int e = 0; e < 8; ++e) ws_[e] = 0.f;
#define FETCH8(dst, tt) do { const int _t = (tt); if (_t >= 0) { const u32x4 _w = *(const u32x4*)(UB + (size_t)(mseq + _t) * WB + n0); \
            dst[0] = pg8::bf_lo(_w.x); dst[1] = pg8::bf_hi(_w.x); dst[2] = pg8::bf_lo(_w.y); dst[3] = pg8::bf_hi(_w.y); dst[4] = pg8::bf_lo(_w.z); dst[5] = pg8::bf_hi(_w.z); dst[6] = pg8::bf_lo(_w.w); dst[7] = pg8::bf_hi(_w.w); } \
          else if (hist) { const f32x4 _a = *(const f32x4*)(hist + (size_t)(15 + _t) * WB + n0), _b = *(const f32x4*)(hist + (size_t)(15 + _t) * WB + n0 + 4); \
            dst[0] = _a.x; dst[1] = _a.y; dst[2] = _a.z; dst[3] = _a.w; dst[4] = _b.x; dst[5] = _b.y; dst[6] = _b.z; dst[7] = _b.w; } \
          else { _Pragma("unroll") for (int _e = 0; _e < 8; ++_e) dst[_e] = 0.f; } } while (0)
        if (t0 >= 15) {
#define UNPK8(dst, _w) do { dst[0] = pg8::bf_lo(_w.x); dst[1] = pg8::bf_hi(_w.x); dst[2] = pg8::bf_lo(_w.y); dst[3] = pg8::bf_hi(_w.y); dst[4] = pg8::bf_lo(_w.z); dst[5] = pg8::bf_hi(_w.z); dst[6] = pg8::bf_lo(_w.w); dst[7] = pg8::bf_hi(_w.w); } while (0)
            const bf16_t* ub = UB + (size_t)(mseq + t0) * WB + n0;
            { u32x4 pre[15];
#pragma unroll
              for (int i = 1; i < 16; ++i) pre[i - 1] = *(const u32x4*)(ub - (size_t)i * WB);
#pragma unroll
              for (int i = 1; i < 16; ++i) { float f[8]; UNPK8(f, pre[i - 1]);
#pragma unroll
                  for (int e = 0; e < 8; ++e) ws_[e] += (i < w) ? f[e] : 0.f; } }
            const float inv = 1.0f / (float)w;
            for (int i0 = 0; i0 < 32; i0 += 4) {
                u32x4 cw[4], ow[4];
#pragma unroll
                for (int k = 0; k < 4; ++k) { cw[k] = *(const u32x4*)(ub + (size_t)(i0 + k) * WB); ow[k] = *(const u32x4*)(ub + (size_t)(i0 + k - w + 1) * WB); }
#pragma unroll
                for (int k = 0; k < 4; ++k) {
                    const int t = t0 + i0 + k; float cur[8], old[8], o[8];
                    UNPK8(cur, cw[k]); UNPK8(old, ow[k]);
#pragma unroll
                    for (int e = 0; e < 8; ++e) { ws_[e] += cur[e]; o[e] = ws_[e] * inv - cur[e]; ws_[e] -= old[e]; }
                    u32x4 pw; pw.x = pk2(o[0], o[1]); pw.y = pk2(o[2], o[3]); pw.z = pk2(o[4], o[5]); pw.w = pk2(o[6], o[7]);
                    *(u32x4*)(MIXB + (size_t)(mseq + t) * DM + n0) = pw;
                    if (t >= L - 15) { float* hp = hout + (size_t)(t - (L - 15)) * WB + n0; *(f32x4*)hp = (f32x4){cur[0], cur[1], cur[2], cur[3]}; *(f32x4*)(hp + 4) = (f32x4){cur[4], cur[5], cur[6], cur[7]}; }
                }
            }
#undef UNPK8
            continue;
        }
        for (int i = 1; i < w; ++i) { float f[8]; FETCH8(f, t0 - i);
#pragma unroll
            for (int e = 0; e < 8; ++e) ws_[e] += f[e]; }
        for (int i = 0; i < 32; ++i) {
            const int t = t0 + i; float cur[8], old[8], o[8];
            FETCH8(cur, t); FETCH8(old, t - w + 1);
            const float inv = 1.0f / (float)(prm ? min(t + 1, w) : w);
#pragma unroll
            for (int e = 0; e < 8; ++e) { ws_[e] += cur[e]; o[e] = ws_[e] * inv - cur[e]; ws_[e] -= old[e]; }
            u32x4 pw; pw.x = pk2(o[0], o[1]); pw.y = pk2(o[2], o[3]); pw.z = pk2(o[4], o[5]); pw.w = pk2(o[6], o[7]);
            *(u32x4*)(MIXB + (size_t)(mseq + t) * DM + n0) = pw;
            if (t >= L - 15) { float* hp = hout + (size_t)(t - (L - 15)) * WB + n0; *(f32x4*)hp = (f32x4){cur[0], cur[1], cur[2], cur[3]}; *(f32x4*)(hp + 4) = (f32x4){cur[4], cur[5], cur[6], cur[7]}; }
        }
#undef FETCH8
    }
}

__device__ __forceinline__ void phase_scan(const Args& a, LAS unsigned char* lds, int l, int G, const int bid, const int tid) {
    const int p = tid & 63, wave = tid >> 6;
    const bf16_t* E = (const bf16_t*)(a.ws + WS_E); bf16_t* AB = (bf16_t*)(a.ws + WS_AB);
    const f32x2* aux = (const f32x2*)(a.ws + WS_AUX);
    LAS f32x2* sL = (LAS f32x2*)lds;
    for (int pair = bid; pair < PB_ * NG; pair += G) {
        const int seq = pair / NG, g = pair % NG;
        const f32x2 lam = aux[(l * NG + g) * NP + p], lseg = aux[2 * NG * NP + (l * NG + g) * NP + p];
        const int j0 = seq * (PL / TS) + wave * 64;
        const unsigned* ep = (const unsigned*)(E + ((size_t)g * NJ + j0) * 128) + p;
        f32x2 h = {0.f, 0.f};
        for (int i0 = 0; i0 < 64; i0 += 16) { unsigned eb[16];
#pragma unroll
            for (int k = 0; k < 16; ++k) eb[k] = ep[(size_t)(i0 + k) * 64];
#pragma unroll
            for (int k = 0; k < 16; ++k) h = cmul(lam, h) + (f32x2){pg8::bf_lo(eb[k]), pg8::bf_hi(eb[k])}; }
        sL[wave * 64 + p] = h;
        __syncthreads();
        f32x2 c = {0.f, 0.f};
        for (int w2 = 0; w2 < wave; ++w2) c = cmul(lseg, c) + sL[w2 * 64 + p];
        h = c;
        unsigned* hp = (unsigned*)(AB + ((size_t)((g >> 1) * NJP + j0) * ABP + (g & 1) * 384 + 256 + 2 * p));
        for (int i0 = 0; i0 < 64; i0 += 16) { unsigned eb[16];
#pragma unroll
            for (int k = 0; k < 16; ++k) eb[k] = ep[(size_t)(i0 + k) * 64];
#pragma unroll
            for (int k = 0; k < 16; ++k) { hp[(size_t)(i0 + k) * (ABP / 2)] = pk2(h.x, h.y); h = cmul(lam, h) + (f32x2){pg8::bf_lo(eb[k]), pg8::bf_hi(eb[k])}; } }
        if (wave == 7) { a.out[O_PRE + (size_t)((l * PB_ + seq) * NG + g) * NP + p] = h.x; a.out[O_PIM + (size_t)((l * PB_ + seq) * NG + g) * NP + p] = h.y; }
        __syncthreads();
    }
    for (int sp = bid * 8 + wave; sp < SB_ * NG; sp += G * 8) {
        const int seq = sp / NG, g = sp % NG;
        const f32x2 lam = aux[(l * NG + g) * NP + p];
        const int j0 = MP / TS + seq * (SL / TS);
        const unsigned* ep = (const unsigned*)(E + ((size_t)g * NJ + j0) * 128) + p;
        const size_t so = (size_t)((l * SB_ + seq) * NG + g) * NP + p;
        f32x2 h = {a.in[2][so], a.in[3][so]};
        unsigned* hp = (unsigned*)(AB + ((size_t)((g >> 1) * NJP + j0) * ABP + (g & 1) * 384 + 256 + 2 * p));
        unsigned es[SL / TS];
#pragma unroll
        for (int i = 0; i < SL / TS; ++i) es[i] = ep[(size_t)i * 64];
#pragma unroll
        for (int i = 0; i < SL / TS; ++i) { hp[(size_t)i * (ABP / 2)] = pk2(h.x, h.y); h = cmul(lam, h) + (f32x2){pg8::bf_lo(es[i]), pg8::bf_hi(es[i])}; }
        a.out[O_SRE + so] = h.x; a.out[O_SIM + so] = h.y;
    }
}

__device__ __forceinline__ void phase_final(const Args& a, int G, const int bid, const int tid) {
    const int lane = tid & 63, wave = tid >> 6;
    const int gw = bid * 8 + wave, NGW = G * 8;
    const float* rsq = (const float*)(a.ws + WS_RSQ) + 4 * (size_t)M; const float* rs3 = (const float*)(a.ws + WS_RSQ) + 3 * (size_t)M;
    f32x4 gv[4];
#pragma unroll
    for (int j = 0; j < 4; ++j) gv[j] = ((const f32x4*)a.in[22])[lane + 64 * j];
    const bf16_t* XB = (const bf16_t*)(a.ws + WS_XB); const float* SL = (const float*)(a.ws + WS_SLAB);
    for (int q = gw; q < MP / 4; q += NGW) {
        u32x2 w[4][4]; float rq[4];
#pragma unroll
        for (int rr = 0; rr < 4; ++rr) { const int m = 4 * q + rr; rq[rr] = rsq[m];
#pragma unroll
            for (int j = 0; j < 4; ++j) w[rr][j] = __builtin_nontemporal_load(((const u32x2*)(XB + (size_t)m * DM)) + lane + 64 * j); }
#pragma unroll
        for (int rr = 0; rr < 4; ++rr) { const int m = 4 * q + rr; const float r = __builtin_amdgcn_rsqf(rq[rr] * (1.0f / DM) + EPS);
            f32x4* yr = (f32x4*)(a.out + O_Y + (size_t)m * DM);
#pragma unroll
            for (int j = 0; j < 4; ++j) { const f32x4 v = {pg8::bf_lo(w[rr][j].x), pg8::bf_hi(w[rr][j].x), pg8::bf_lo(w[rr][j].y), pg8::bf_hi(w[rr][j].y)}; __builtin_nontemporal_store(v * r * gv[j], yr + lane + 64 * j); } }
    }
    for (int m = MP + gw; m < M; m += NGW) {
        f32x4 v[4];
#pragma unroll
        for (int j = 0; j < 4; ++j) { const u32x2 w = ((const u32x2*)(XB + (size_t)m * DM))[lane + 64 * j]; v[j] = (f32x4){pg8::bf_lo(w.x), pg8::bf_hi(w.x), pg8::bf_lo(w.y), pg8::bf_hi(w.y)}; }
        float ss = 0.f; const float r2s = __builtin_amdgcn_rcpf(rs3[m] * (1.0f / DM) + EPS);
#pragma unroll
        for (int j = 0; j < 4; ++j) {
            f32x4 p = {0.f, 0.f, 0.f, 0.f};
#pragma unroll
            for (int z = 0; z < 8; ++z) p += ((const f32x4*)(SL + ((size_t)z * MS + (m - MP)) * DM))[lane + 64 * j];
            v[j] += p * r2s;
            ss += (v[j].x * v[j].x + v[j].y * v[j].y) + (v[j].z * v[j].z + v[j].w * v[j].w); }
        const float r = __builtin_amdgcn_rsqf(wave_sum(ss) * (1.0f / DM) + EPS);
        f32x4* yr = (f32x4*)(a.out + O_Y + (size_t)m * DM);
#pragma unroll
        for (int j = 0; j < 4; ++j) __builtin_nontemporal_store(v[j] * r * gv[j], yr + lane + 64 * j);
    }
}

__device__ __forceinline__ void phase_sample_finalize(const Args& a, unsigned char* ws, int G, const int bid, const int tid) {
    const int lane = tid & 63, wave = tid >> 6;
    bf16_t* XB = (bf16_t*)(ws + WS_XB); const float* SL = (const float*)(ws + WS_SLAB); float* rsq = (float*)(ws + WS_RSQ) + 2 * (size_t)M; const float* rs1 = (const float*)(ws + WS_RSQ) + (size_t)M;
    for (int r = bid * 8 + wave; r < MS; r += G * 8) {
        const int m = MP + r; float ss = 0.f; u32x2 o[4];
        const float r2 = __builtin_amdgcn_rcpf(rs1[m] * (1.0f / DM) + EPS);
#pragma unroll
        for (int j = 0; j < 4; ++j) { const u32x2 w = ((const u32x2*)(XB + (size_t)m * DM))[lane + 64 * j]; f32x4 v = {pg8::bf_lo(w.x), pg8::bf_hi(w.x), pg8::bf_lo(w.y), pg8::bf_hi(w.y)};
            f32x4 p = {0.f, 0.f, 0.f, 0.f};
#pragma unroll
            for (int z = 0; z < 8; ++z) p += ((const f32x4*)(SL + ((size_t)z * MS + r) * DM))[lane + 64 * j];
            v += p * r2;
            ss += (v.x * v.x + v.y * v.y) + (v.z * v.z + v.w * v.w); o[j] = (u32x2){pk2(v.x, v.y), pk2(v.z, v.w)}; }
#pragma unroll
        for (int j = 0; j < 4; ++j) ((u32x2*)(XB + (size_t)m * DM))[lane + 64 * j] = o[j];
        ss = wave_sum(ss);
        if (lane == 0) rsq[m] = ss;
    }
}

#define XB_TMO      128
#define XB_XCNT(j)  (256  + 64 * (j))
#define XB_XSUB(j)  (1280 + 64 * (j))
#define XB_XGEN(j)  (2304 + 64 * (j))
#define XB_TOP      3328
#define XB_TOPGEN   3392
#define XCD_BAR_WORDS 3456
#define XB_SPIN_CAP (1u << 18)
__device__ __forceinline__ unsigned xb_ld(unsigned* p)              { return __hip_atomic_load(p, __ATOMIC_RELAXED, __HIP_MEMORY_SCOPE_AGENT); }
__device__ __forceinline__ unsigned xb_add(unsigned* p, unsigned v) { return __hip_atomic_fetch_add(p, v, __ATOMIC_RELAXED, __HIP_MEMORY_SCOPE_AGENT); }
__device__ __forceinline__ unsigned xb_xcc_id() { return (unsigned)__builtin_amdgcn_s_getreg((3 << 11) | 20) & 0xFu; }
#define XB_SPIN(cond, bar) do { unsigned _sp = 0; while (cond) { __builtin_amdgcn_s_sleep(1); \
    if ((++_sp & 255u) == 0u) { if (xb_ld(&(bar)[XB_TMO])) break; if (_sp > XB_SPIN_CAP) { atomicAdd(&(bar)[XB_TMO], 1u); break; } } } } while (0)
struct XcdBarrier { unsigned* bar; unsigned x; volatile LAS unsigned* st; };
__device__ __forceinline__ XcdBarrier xcd_barrier_post(unsigned* bar, volatile LAS unsigned* st) {
    XcdBarrier b; b.bar = bar; b.x = xb_xcc_id(); b.st = st;
    if (threadIdx.x == 0) (void)xb_add(&bar[XB_XCNT(b.x)], 1u);
    return b;
}
__device__ __forceinline__ void xcd_barrier_complete(unsigned* bar, unsigned x, unsigned& nloc, unsigned& nx) {
    const unsigned G = gridDim.x * gridDim.y * gridDim.z;
    unsigned sum, cnt, mine, sp = 0u;
    for (;;) {
        sum = 0u; cnt = 0u; mine = 0u;
#pragma unroll
        for (unsigned j = 0; j < 16; ++j) { const unsigned c = xb_ld(&bar[XB_XCNT(j)]); sum += c; cnt += (c > 0u) ? 1u : 0u; mine = (j == x) ? c : mine; }
        if (sum == G) break;
        __builtin_amdgcn_s_sleep(1);
        if ((++sp & 255u) == 0u) { if (xb_ld(&bar[XB_TMO])) break; if (sp > XB_SPIN_CAP) { atomicAdd(&bar[XB_TMO], 1u); break; } }
    }
    nloc = mine > 0u ? mine : 1u; nx = cnt > 0u ? cnt : 1u;
}
__device__ __forceinline__ void xcd_barrier(const XcdBarrier& b) {
    asm volatile("s_waitcnt vmcnt(0)" ::: "memory");
    __syncthreads();
    if (threadIdx.x == 0) {
        unsigned* bar = b.bar;
        __builtin_amdgcn_s_waitcnt(0);
        unsigned nloc = b.st[0], nx = b.st[1];
        if (nloc == 0u) { xcd_barrier_complete(bar, b.x, nloc, nx); b.st[0] = nloc; b.st[1] = nx; }
        const unsigned old = xb_add(&bar[XB_XSUB(b.x)], 1u);
        const unsigned gen = old / nloc;
        if (old + 1u == (gen + 1u) * nloc) {
            __builtin_amdgcn_fence(__ATOMIC_RELEASE, "agent");
            asm volatile("s_waitcnt vmcnt(0)" ::: "memory");
            const unsigned og = xb_add(&bar[XB_TOP], 1u);
            const unsigned tg = og / nx;
            if (og + 1u == (tg + 1u) * nx) xb_add(&bar[XB_TOPGEN], 1u);
            else XB_SPIN(xb_ld(&bar[XB_TOPGEN]) == tg, bar);
            __builtin_amdgcn_fence(__ATOMIC_ACQUIRE, "agent");
            xb_add(&bar[XB_XGEN(b.x)], 1u);
            asm volatile("s_waitcnt vmcnt(0)" ::: "memory");
        } else {
            XB_SPIN(xb_ld(&bar[XB_XGEN(b.x)]) == gen, bar);
            __builtin_amdgcn_fence(__ATOMIC_ACQUIRE, "agent");
            asm volatile("s_waitcnt vmcnt(0)" ::: "memory");
        }
    }
    __syncthreads();
}

__device__ __forceinline__ void handoff_publish(unsigned* cnt) {
    if (threadIdx.x == 0) { __builtin_amdgcn_fence(__ATOMIC_RELEASE, "agent"); asm volatile("s_waitcnt vmcnt(0)" ::: "memory"); (void)xb_add(cnt, 1u); }
}
__device__ __forceinline__ void handoff_wait(unsigned* cnt, unsigned want, unsigned* tmo) {
    if (threadIdx.x == 0) { XB_SPIN(xb_ld(cnt) < want, tmo - XB_TMO); __builtin_amdgcn_fence(__ATOMIC_ACQUIRE, "agent"); asm volatile("s_waitcnt vmcnt(0)" ::: "memory"); }
    __syncthreads();
}

__global__ void __launch_bounds__(512, 2) fwd_kernel(Args a) {
    extern __shared__ __attribute__((aligned(16))) unsigned char lds_raw[];
    LAS unsigned char* lds = (LAS unsigned char*)lds_raw;
    const int G = gridDim.x;
    volatile LAS unsigned* bst = (volatile LAS unsigned*)(lds + 131072 + 64);
    if (threadIdx.x < 2) bst[threadIdx.x] = 0u;
    __syncthreads();
    XcdBarrier bar = xcd_barrier_post((unsigned*)(a.ws + WS_BAR), bst);
#define RELAUNDER() do { size_t wz_ = 0; asm volatile("" : "+s"(wz_), "+v"(tid)); ws = a.ws + wz_; rsq = (float*)(ws + WS_RSQ); XB = (bf16_t*)(ws + WS_XB); AB = (bf16_t*)(ws + WS_AB); Z = (bf16_t*)(ws + WS_Z); MIX = (bf16_t*)(ws + WS_MIX); H = (bf16_t*)(ws + WS_H); wl = ws + WS_W + (size_t)l * WL_SZ; } while (0)
    for (int ph = a.ph_lo; ph < a.ph_hi; ++ph) {
        int tid = threadIdx.x, cidx = blockIdx.x;
        size_t wz = 0;
        asm volatile("" : "+s"(wz), "+v"(tid), "+v"(cidx));
        unsigned char* ws = a.ws + wz;
        cidx = __builtin_amdgcn_readfirstlane(cidx);
        float* rsq = (float*)(ws + WS_RSQ);
        bf16_t* XB = (bf16_t*)(ws + WS_XB); bf16_t* UB = (bf16_t*)(ws + WS_UB); bf16_t* AB = (bf16_t*)(ws + WS_AB);
        bf16_t* Eb = (bf16_t*)(ws + WS_E); bf16_t* Z = (bf16_t*)(ws + WS_Z); bf16_t* MIX = (bf16_t*)(ws + WS_MIX); bf16_t* H = (bf16_t*)(ws + WS_H);
        if (ph == 0) phase_prologue(a, lds, G, cidx, tid);
        else if (ph == NPH - 1) phase_final(a, G, cidx, tid);
        else if (ph == 9) phase_sample_finalize(a, ws, G, cidx, tid);
        else {
            const int l = ph > 9 ? 1 : 0, k = ph > 9 ? ph - 10 : ph - 1;
            const unsigned char* wl = ws + WS_W + (size_t)l * WL_SZ;
            if (k == 0) {
                pg8::Gemm g{XB, (const bf16_t*)(wl + WL_IN), DM, DM, DM, M / 256, DM / 256, 1, 0, 0, 0, 0};
                pg8::EpiIn E{rsq + (size_t)(2 * l) * M, AB, UB};
                pg8::gemm_phase(lds, g, G, cidx, tid, E);
                if (l == 0) phase_prologue_rest(a, lds, G, cidx, tid);
            } else if (k == 1) {
                pg8::Gemm g{AB, (const bf16_t*)(wl + WL_WE), ABP, ABP, ABP, NJP / 256, 1, 16, 0, (size_t)NJP * ABP * 2, 0, (size_t)256 * ABP * 2};
                pg8::EpiE E{Eb};
                pg8::gemm_phase(lds, g, G, cidx, tid, E);
                phase_diff(a, l, G, cidx, tid);
            } else if (k == 2) phase_scan(a, lds, l, G, cidx, tid);
            else if (k == 3) {
                unsigned* hcnt = (unsigned*)(a.ws + WS_BAR) + 3456 + 64 * (2 + l);
                { pg8::Gemm g{AB + (size_t)16 * 256 * ABP, (const bf16_t*)(wl + WL_TY), ABP, 384, 384, 1, 1, 32, 1, (size_t)NJP * ABP * 2, (size_t)384 * 2, (size_t)256 * 384 * 2};
                  pg8::EpiY<16 * 256> E{AB, a.in[15] + l * WA, Z};
                  pg8::gemm_phase(lds, g, G, cidx, tid, E);
                  if (cidx < 32) handoff_publish(hcnt); }
                RELAUNDER();
                { pg8::Gemm g{AB, (const bf16_t*)(wl + WL_TY), ABP, 384, 384, 16, 1, 32, 1, (size_t)NJP * ABP * 2, (size_t)384 * 2, (size_t)256 * 384 * 2};
                  pg8::EpiY<0> E{AB, a.in[15] + l * WA, Z};
                  pg8::gemm_phase(lds, g, G, cidx, tid, E); }
                RELAUNDER();
                { const int c3 = (cidx + G - 32) % G;
                  if (c3 < (MS / 256) * (WA / 256)) handoff_wait(hcnt, 32u, (unsigned*)(a.ws + WS_BAR) + XB_TMO);
                  pg8::Gemm g{Z + (size_t)MP * WA, (const bf16_t*)(wl + WL_GLU), WA, WA, WA, MS / 256, WA / 256, 1, 0, 0, 0, 0};
                  pg8::EpiGlu E{Z + (size_t)MP * WA, MIX + (size_t)MP * DM}; pg8::gemm_phase(lds, g, G, c3, tid, E); }
            } else if (k == 4) {
                pg8::Gemm g{Z, (const bf16_t*)(wl + WL_GLU), WA, WA, WA, MP / 256, WA / 256, 1, 0, 0, 0, 0};
                pg8::EpiGlu E{Z, MIX}; pg8::gemm_phase(lds, g, G, cidx, tid, E);
            } else if (k == 5) {
                unsigned* hcnt = (unsigned*)(a.ws + WS_BAR) + 3456 + 64 * l;
                { pg8::Gemm g{MIX + (size_t)MP * DM, (const bf16_t*)(wl + WL_OUT), DM, DM, DM, MS / 256, DM / 256, 1, 0, 0, 0, 0};
                  pg8::EpiRes<false> E{XB + (size_t)MP * DM, rsq + (size_t)(2 * l + 1) * M + MP, nullptr};
                  pg8::gemm_phase(lds, g, G, cidx, tid, E);
                  if (cidx < (MS / 256) * (DM / 256)) handoff_publish(hcnt); }
                { pg8::Gemm g{MIX, (const bf16_t*)(wl + WL_OUT), DM, DM, DM, MP / 256, DM / 256, 1, 0, 0, 0, 0};
                  pg8::EpiRes<false> E{XB, rsq + (size_t)(2 * l + 1) * M, nullptr};
                  pg8::gemm_phase(lds, g, G, cidx, tid, E); }
                { const int c3 = (cidx + G - 32) % G;
                  if (c3 < (MS / 256) * (FF / 256)) handoff_wait(hcnt, (MS / 256) * (DM / 256), (unsigned*)(a.ws + WS_BAR) + XB_TMO);
                  pg8::Gemm g{XB + (size_t)MP * DM, (const bf16_t*)(wl + WL_W1), DM, DM, DM, MS / 256, FF / 256, 1, 0, 0, 0, 0};
                  pg8::EpiFF1 E{H + (size_t)MP * FF};
                  pg8::gemm_phase(lds, g, G, c3, tid, E); }
            } else if (k == 6) {
                pg8::Gemm g{XB, (const bf16_t*)(wl + WL_W1), DM, DM, DM, MP / 256, FF / 256, 1, 0, 0, 0, 0};
                pg8::EpiFF1 E{H};
                pg8::gemm_phase(lds, g, G, cidx, tid, E);
            } else {
                { pg8::Gemm g{H, (const bf16_t*)(wl + WL_W2), FF, FF, FF, MP / 256, DM / 256, 1, 0, 0, 0, 0};
                  pg8::EpiRes<true> E{XB, rsq + (size_t)(2 * l + 2) * M, rsq + (size_t)(2 * l + 1) * M};
                  pg8::gemm_phase(lds, g, G, cidx, tid, E); }
                { pg8::Gemm g{H + (size_t)MP * FF, (const bf16_t*)(wl + WL_W2), FF, FF, 512, MS / 256, DM / 256, 8, 0, (size_t)512 * 2, 0, (size_t)512 * 2};
                  pg8::EpiSlab E{(float*)(ws + WS_SLAB)};
                  pg8::gemm_phase(lds, g, G, cidx, tid, E); }
            }
        }
        if (ph + 1 < a.ph_hi) {
            if (a.ph_lo < 0) cg::this_grid().sync();
            xcd_barrier(bar);
        }
    }
}

extern "C" void kernel_launch(void* const* d_in, const int* in_sizes, int n_in, void* d_out, int out_size, void* d_ws, size_t ws_size, hipStream_t stream) {
    static int grid = 0;
    if (grid == 0) {
        if (n_in != 23 || ws_size < WS_END) { fprintf(stderr, "kernel_launch: n_in %d ws %zu (need %zu)\n", n_in, ws_size, (size_t)WS_END); grid = -1; return; }
        int dev = 0, cus = 0, per_cu = 0;
        hipGetDevice(&dev); hipDeviceGetAttribute(&cus, hipDeviceAttributeMultiprocessorCount, dev);
        hipFuncSetAttribute((const void*)fwd_kernel, hipFuncAttributeMaxDynamicSharedMemorySize, LDS_BYTES);
        hipOccupancyMaxActiveBlocksPerMultiprocessor(&per_cu, (const void*)fwd_kernel, 512, LDS_BYTES);
        if (per_cu < 1) per_cu = 1;
        (void)hipGetLastError();
        grid = cus * per_cu;
    }
    if (grid < 0) return;
    Args a{};
    for (int i = 0; i < 23; ++i) a.in[i] = (const float*)d_in[i];
    a.out = (float*)d_out; a.ws = (unsigned char*)d_ws;
#if MK_PER_PHASE
    for (int ph = 0; ph < NPH; ++ph) { a.ph_lo = ph; a.ph_hi = ph + 1; hipLaunchKernelGGL(fwd_kernel, dim3(grid), dim3(512), LDS_BYTES, stream, a); }
#else
    a.ph_lo = 0; a.ph_hi = NPH;
    void* args[] = {&a};
    (void)hipMemsetAsync((char*)d_ws + WS_BAR, 0, (3456 + 256) * 4, stream);
    hipError_t e = hipLaunchCooperativeKernel((const void*)fwd_kernel, dim3(grid), dim3(512), args, LDS_BYTES, stream);
    if (e != hipSuccess) fprintf(stderr, "cooperative launch failed: %s (grid %d)\n", hipGetErrorString(e), grid);
#endif
}
```

```cpp
#include <hip/hip_runtime.h>
#include <hip/hip_cooperative_groups.h>
#include <cstdio>
#include <cstdint>
namespace cg = cooperative_groups;

#ifndef MK_PER_PHASE
#define MK_PER_PHASE 0
#endif

#define LAS __attribute__((address_space(3)))
typedef unsigned short bf16_t;
typedef short bf16x8 __attribute__((ext_vector_type(8)));
typedef float f32x4 __attribute__((ext_vector_type(4)));
typedef float f32x2 __attribute__((ext_vector_type(2)));
typedef unsigned u32x4 __attribute__((ext_vector_type(4)));
typedef unsigned u32x2 __attribute__((ext_vector_type(2)));

constexpr int DM = 1024, FF = 4096, WA = 512, WB = 512;
constexpr int PB_ = 8, PL = 8192, SB_ = 32, SL = 64;
constexpr int MP = PB_ * PL, MS = SB_ * SL, M = MP + MS;
constexpr int TS = 16;
constexpr int NJ = M / TS;
constexpr int NJP = 4352;
constexpr int ABP = 768;
constexpr int NG = 32, NP = 64;
constexpr float EPS = 1e-5f;
constexpr int NPH = 19;

constexpr size_t O_Y = 0;
constexpr size_t O_PRE = (size_t)M * DM;
constexpr size_t O_PIM = O_PRE + 2 * PB_ * NG * NP;
constexpr size_t O_PPOOL = O_PIM + 2 * PB_ * NG * NP;
constexpr size_t O_SRE = O_PPOOL + 2 * PB_ * 15 * WB;
constexpr size_t O_SIM = O_SRE + 2 * SB_ * NG * NP;
constexpr size_t O_SPOOL = O_SIM + 2 * SB_ * NG * NP;

constexpr size_t MiB = 1u << 20;
constexpr size_t WS_RSQ = 0;
constexpr size_t WS_AUX = 2 * MiB;
constexpr size_t WS_BAR = 3 * MiB;
constexpr size_t WS_W = 4 * MiB;
constexpr size_t WL_IN = 0, WL_GLU = 2 * MiB, WL_POOL = 2 * MiB + 512 * 1024, WL_OUT = 3 * MiB, WL_W1 = 5 * MiB, WL_W2 = 13 * MiB, WL_WE = 21 * MiB, WL_TY = 27 * MiB, WL_SZ = 33 * MiB;
constexpr size_t WS_XB = 72 * MiB;
constexpr size_t WS_H = 204 * MiB;
constexpr size_t WS_UB = WS_H;
constexpr size_t WS_AB = WS_H + 66 * MiB;
constexpr size_t WS_E = WS_H + 168 * MiB;
constexpr size_t WS_Z = WS_H + 234 * MiB;
constexpr size_t WS_DIFF = WS_H + 300 * MiB;
constexpr size_t WS_MIX = WS_H + 366 * MiB;
constexpr size_t WS_SLAB = WS_H + 528 * MiB;
constexpr size_t WS_END = WS_SLAB + 64 * MiB;
static_assert((size_t)16 * NJP * ABP * 2 <= 102 * MiB && (size_t)32 * NJ * 128 * 4 <= 66 * MiB && (size_t)M * 512 * 2 <= 66 * MiB, "ws map");

constexpr int LDS_BYTES = 147456;

namespace pg8 {
constexpr int BM = 256, BK = 64, HALF = 128, HTB = HALF * BK * 2, STAGE_BYTES = 8 * HTB, NXCD = 8, WGM = 8;

__host__ __device__ __forceinline__ int lds_byte(int r, int c) { const int st = (r >> 4) * 2 + (c >> 5), rr = r & 15, cc = c & 31, ob = rr * 64 + cc * 2; return st * 1024 + (ob ^ (((ob >> 9) & 1) << 5)); }
__host__ __device__ __forceinline__ void stage_rc(int b, int& R, int& C) { const int st = b / 1024, sb = b % 1024, swz = sb ^ (((sb >> 9) & 1) << 5); R = (st >> 1) * 16 + swz / 64; C = (st & 1) * 32 + (swz % 64) / 2; }
__host__ __device__ __forceinline__ int perm32(int rho) { const int n = rho >> 4, i = rho & 15; return 8 * (i >> 2) + 4 * n + (i & 3); }

struct Unit { int pm, pn, pz; };
struct Gemm { const bf16_t* A; const bf16_t* Bt; int lda, ldb, K, nM, nN, nZ, zs; size_t sAhi, sAlo, sB; };

struct StaticOrder {
    int nM, nMt, nN, nwg, G, c;
    __device__ __forceinline__ void init(const Gemm& g, int G_, int c_) { nM = g.nM; nMt = g.nM * g.nZ; nN = g.nN; nwg = nMt * nN; G = G_; c = c_; }
    __device__ __forceinline__ bool next(int i, Unit& u) const {
        const long L = (long)i * G + c; if (L >= nwg) return false;
        int wgid = (int)L; { const int q = nwg / NXCD, r = nwg % NXCD, xcd = wgid % NXCD, off = wgid / NXCD; wgid = (xcd < r ? xcd * (q + 1) : r * (q + 1) + (xcd - r) * q) + off; }
        const int nig = WGM * nN, gid = wgid / nig, fm = gid * WGM, gsz = (nMt - fm) < WGM ? (nMt - fm) : WGM;
        const int pmt = fm + ((wgid % nig) % gsz); u.pn = (wgid % nig) / gsz; u.pz = pmt / nM; u.pm = pmt - u.pz * nM; return true;
    }
};

__device__ __forceinline__ unsigned cvt_pk_bf16(float lo, float hi) { unsigned r; asm volatile("v_cvt_pk_bf16_f32 %0, %1, %2" : "=v"(r) : "v"(lo), "v"(hi)); return r; }
__device__ __forceinline__ float bf_lo(unsigned w) { return __uint_as_float(w << 16); }
__device__ __forceinline__ float bf_hi(unsigned w) { return __uint_as_float(w & 0xffff0000u); }
__device__ __forceinline__ u32x4 pack8(const f32x4 a, const f32x4 b) { u32x4 w; w.x = cvt_pk_bf16(a[0], a[1]); w.y = cvt_pk_bf16(a[2], a[3]); w.z = cvt_pk_bf16(b[0], b[1]); w.w = cvt_pk_bf16(b[2], b[3]); return w; }

#define EPI_ARGS const f32x4 (&acc)[2][2][4][2], const Unit& u, int wr, int wc, int fr, int fq

struct EpiIn {
    const float* rsq; bf16_t* AB; bf16_t* UB;
    __device__ __forceinline__ void operator()(EPI_ARGS) const {
        const int row0 = u.pm * BM + wr * 64 + fr, colt = u.pn * BM + wc * 32 + 8 * fq;
        float rs[2][4];
#pragma unroll
        for (int ai = 0; ai < 2; ++ai)
#pragma unroll
            for (int m = 0; m < 4; ++m) rs[ai][m] = rsq[row0 + ai * HALF + m * 16];
#pragma unroll
        for (int ai = 0; ai < 2; ++ai)
#pragma unroll
            for (int m = 0; m < 4; ++m) {
                const int row = row0 + ai * HALF + m * 16;
                const float r = __builtin_amdgcn_rsqf(rs[ai][m] * (1.0f / DM) + EPS);
#pragma unroll
                for (int bj = 0; bj < 2; ++bj) {
                    const int col = colt + bj * HALF;
                    const u32x4 w = pack8(acc[ai][bj][m][0] * r, acc[ai][bj][m][1] * r);
                    if (u.pn < 2) { const int g = col >> 4, c = col & 15; *(u32x4*)(AB + ((size_t)((g >> 1) * NJP + (row >> 4)) * ABP + (g & 1) * 384 + (row & 15) * 16 + c)) = w; }
                    else *(u32x4*)(UB + (size_t)row * WB + (col - WA)) = w;
                }
            }
    }
};
struct EpiE {
    bf16_t* E;
    __device__ __forceinline__ void operator()(EPI_ARGS) const {
        const int row0 = u.pm * BM + wr * 64 + fr, colt = wc * 32 + 8 * fq;
#pragma unroll
        for (int ai = 0; ai < 2; ++ai)
#pragma unroll
            for (int m = 0; m < 4; ++m) {
                const int j = row0 + ai * HALF + m * 16;
                if (j < NJ) {
#pragma unroll
                    for (int bj = 0; bj < 2; ++bj)
                        *(u32x4*)(E + ((size_t)(2 * u.pz + bj) * NJ + j) * 128 + colt) = pack8(acc[ai][bj][m][0], acc[ai][bj][m][1]);
                }
            }
    }
};
template <int JB> struct EpiY {
    static constexpr bool A_TILED = false;
    const bf16_t* AB; const float* dvec; bf16_t* Z;
    __device__ __forceinline__ void operator()(EPI_ARGS) const {
        const int g = u.pz; const int row0 = JB + u.pm * BM + wr * 64 + fr, colt = wc * 32 + 8 * fq;
#pragma unroll
        for (int bj = 0; bj < 2; ++bj) {
            const int n = colt + bj * HALF, t = n >> 4, c = n & 15;
            const f32x4 d0 = *(const f32x4*)(dvec + g * 16 + c), d1 = *(const f32x4*)(dvec + g * 16 + c + 4);
#pragma unroll
            for (int ai = 0; ai < 2; ++ai) {
                u32x4 uw[4];
#pragma unroll
                for (int m = 0; m < 4; ++m) { const int j = row0 + ai * HALF + m * 16;
                    uw[m] = (j < NJ) ? *(const u32x4*)(AB + ((size_t)((g >> 1) * NJP + j) * ABP + (g & 1) * 384 + n)) : (u32x4){0u, 0u, 0u, 0u}; }
#pragma unroll
                for (int m = 0; m < 4; ++m) { const int j = row0 + ai * HALF + m * 16;
                    if (j < NJ) {
                        const u32x4 w = uw[m];
                        f32x4 u0 = {bf_lo(w.x), bf_hi(w.x), bf_lo(w.y), bf_hi(w.y)}, u1 = {bf_lo(w.z), bf_hi(w.z), bf_lo(w.w), bf_hi(w.w)};
                        f32x4 y0 = acc[ai][bj][m][0] + d0 * u0, y1 = acc[ai][bj][m][1] + d1 * u1;
#pragma unroll
                        for (int e = 0; e < 4; ++e) {
                            { const float y = y0[e], q = 1.5957691216f * (y + 0.044715f * y * y * y); y0[e] = y * __builtin_amdgcn_rcpf(1.0f + __expf(-q)); }
                            { const float y = y1[e], q = 1.5957691216f * (y + 0.044715f * y * y * y); y1[e] = y * __builtin_amdgcn_rcpf(1.0f + __expf(-q)); }
                        }
                        *(u32x4*)(Z + (size_t)(j * TS + t) * WA + g * 16 + c) = pack8(y0, y1);
                    }
                }
            }
        }
    }
};
struct EpiGlu {
    const bf16_t* Z; bf16_t* MIX;
    __device__ __forceinline__ void operator()(EPI_ARGS) const {
        const int row0 = u.pm * BM + wr * 64 + fr, colt = u.pn * BM + wc * 32 + 8 * fq;
#pragma unroll
        for (int ai = 0; ai < 2; ++ai) {
            u32x4 zw[4][2];
#pragma unroll
            for (int m = 0; m < 4; ++m)
#pragma unroll
                for (int bj = 0; bj < 2; ++bj) zw[m][bj] = *(const u32x4*)(Z + (size_t)(row0 + ai * HALF + m * 16) * WA + colt + bj * HALF);
#pragma unroll
            for (int m = 0; m < 4; ++m) {
                const int row = row0 + ai * HALF + m * 16;
#pragma unroll
                for (int bj = 0; bj < 2; ++bj) {
                    f32x4 a0 = acc[ai][bj][m][0], a1 = acc[ai][bj][m][1];
                    const u32x4 w = zw[m][bj];
                    const f32x4 z0 = {bf_lo(w.x), bf_hi(w.x), bf_lo(w.y), bf_hi(w.y)}, z1 = {bf_lo(w.z), bf_hi(w.z), bf_lo(w.w), bf_hi(w.w)};
#pragma unroll
                    for (int e = 0; e < 4; ++e) { a0[e] = z0[e] * __builtin_amdgcn_rcpf(1.0f + __expf(-a0[e])); a1[e] = z1[e] * __builtin_amdgcn_rcpf(1.0f + __expf(-a1[e])); }
                    *(u32x4*)(MIX + (size_t)row * DM + colt + bj * HALF) = pack8(a0, a1);
                }
            }
        }
    }
};
template <bool SC> struct EpiRes {
    bf16_t* XB; float* rsq; const float* rsc;
    __device__ __forceinline__ void operator()(EPI_ARGS) const {
        const int row0 = u.pm * BM + wr * 64 + fr, colt = u.pn * BM + wc * 32 + 8 * fq;
        float ssum[2][4];
#pragma unroll
        for (int ai = 0; ai < 2; ++ai) {
            u32x4 xw[4][2]; float sc[4];
#pragma unroll
            for (int m = 0; m < 4; ++m) {
                sc[m] = SC ? rsc[row0 + ai * HALF + m * 16] : 0.f;
#pragma unroll
                for (int bj = 0; bj < 2; ++bj) xw[m][bj] = *(const u32x4*)(XB + (size_t)(row0 + ai * HALF + m * 16) * DM + colt + bj * HALF);
            }
#pragma unroll
            for (int m = 0; m < 4; ++m) {
                const int row = row0 + ai * HALF + m * 16;
                const float r2 = SC ? __builtin_amdgcn_rcpf(sc[m] * (1.0f / DM) + EPS) : 1.0f;
                float ss = 0.f;
#pragma unroll
                for (int bj = 0; bj < 2; ++bj) {
                    const u32x4 w = xw[m][bj];
                    const f32x4 x0 = (f32x4){bf_lo(w.x), bf_hi(w.x), bf_lo(w.y), bf_hi(w.y)} + acc[ai][bj][m][0] * r2, x1 = (f32x4){bf_lo(w.z), bf_hi(w.z), bf_lo(w.w), bf_hi(w.w)} + acc[ai][bj][m][1] * r2;
                    *(u32x4*)(XB + (size_t)row * DM + colt + bj * HALF) = pack8(x0, x1);
                    ss += (x0[0] * x0[0] + x0[1] * x0[1]) + (x0[2] * x0[2] + x0[3] * x0[3]) + (x1[0] * x1[0] + x1[1] * x1[1]) + (x1[2] * x1[2] + x1[3] * x1[3]);
                }
                ss += __shfl_xor(ss, 16); ss += __shfl_xor(ss, 32);
                ssum[ai][m] = ss;
            }
        }
        const float s0 = fq == 0 ? ssum[0][0] : fq == 1 ? ssum[0][2] : fq == 2 ? ssum[1][0] : ssum[1][2];
        const float s1 = fq == 0 ? ssum[0][1] : fq == 1 ? ssum[0][3] : fq == 2 ? ssum[1][1] : ssum[1][3];
        const int k0 = 2 * fq, k1 = 2 * fq + 1;
        atomicAdd(rsq + row0 + (k0 >> 2) * HALF + (k0 & 3) * 16, s0);
        atomicAdd(rsq + row0 + (k1 >> 2) * HALF + (k1 & 3) * 16, s1);
    }
};
struct EpiSlab {
    bf16_t* S;
    __device__ __forceinline__ void operator()(EPI_ARGS) const {
        const int row0 = u.pm * BM + wr * 64 + fr, colt = u.pn * BM + wc * 32 + 8 * fq;
#pragma unroll
        for (int ai = 0; ai < 2; ++ai)
#pragma unroll
            for (int m = 0; m < 4; ++m)
#pragma unroll
                for (int bj = 0; bj < 2; ++bj)
                    *(u32x4*)(S + ((size_t)u.pz * MS + row0 + ai * HALF + m * 16) * DM + colt + bj * HALF) = pack8(acc[ai][bj][m][0], acc[ai][bj][m][1]);
    }
};
struct EpiFF1 {
    bf16_t* H;
    __device__ __forceinline__ void operator()(EPI_ARGS) const {
        const int row0 = u.pm * BM + wr * 64 + fr, colt = u.pn * BM + wc * 32 + 8 * fq;
#pragma unroll
        for (int ai = 0; ai < 2; ++ai)
#pragma unroll
            for (int m = 0; m < 4; ++m) {
                const int row = row0 + ai * HALF + m * 16;
#pragma unroll
                for (int bj = 0; bj < 2; ++bj) {
                    f32x4 a0 = acc[ai][bj][m][0], a1 = acc[ai][bj][m][1];
#pragma unroll
                    for (int e = 0; e < 4; ++e) { const float p = fmaxf(a0[e], 0.f), q = fmaxf(a1[e], 0.f); a0[e] = p * p; a1[e] = q * q; }
                    __builtin_nontemporal_store(pack8(a0, a1), (u32x4*)(H + (size_t)row * FF + colt + bj * HALF));
                }
            }
    }
};

template <class Epi>
__device__ __forceinline__ void gemm_phase(LAS unsigned char* lds, const Gemm g, const int G, const int cidx, const int tid, const Epi& E) {
    const int wid = __builtin_amdgcn_readfirstlane(tid >> 6), lane = tid & 63, wr = wid >> 2, wc = wid & 3, fr = lane & 15, fq = lane >> 4;
    const int K = g.K, nt = K / BK;
    StaticOrder S; S.init(g, G, cidx);
    unsigned voffA[2], voffB[2];
#pragma unroll
    for (int i = 0; i < 2; ++i) { int R, C; stage_rc(tid * 16 + i * 8192, R, C); const int Rb = (R & ~31) + perm32(R & 31);
        voffA[i] = (unsigned)(R * g.lda + C) * 2u; voffB[i] = (unsigned)(Rb * g.ldb + C) * 2u; }
    const size_t kstep = (size_t)(BK * 2);
    const size_t hstepA = (size_t)HALF * g.lda * 2, hstepB = (size_t)HALF * g.ldb * 2;
    const size_t tstepA = 2 * hstepA, tstepB = 2 * hstepB;
    const unsigned ldsw = (unsigned)wid * 1024u;
    const int aoff = lds_byte(wr * 64 + fr, fq * 8), boff = lds_byte(wc * 32 + fr, fq * 8);
    const int zmask = (1 << g.zs) - 1;
#define PG8_SA(b, h) (((b) * 2 + (h)) * HTB)
#define PG8_SB(b, h) ((4 + (b) * 2 + (h)) * HTB)
#define PG8_STAGE(bufoff, gbase, voff) do { _Pragma("unroll") for (int _i = 0; _i < 2; ++_i) \
        __builtin_amdgcn_global_load_lds((const unsigned*)((const char*)(gbase) + (voff)[_i]), (LAS unsigned*)(lds + (bufoff) + ldsw + _i * 8192), 16, 0, 0); } while (0)
#define PG8_LDA(dst, b, h) do { _Pragma("unroll") for (int m = 0; m < 4; ++m) _Pragma("unroll") for (int k = 0; k < 2; ++k) dst[m][k] = *(const LAS bf16x8*)(lds + PG8_SA(b, h) + aoff + m * 2048 + k * 1024); } while (0)
#define PG8_LDB(dst, b, h) do { _Pragma("unroll") for (int n = 0; n < 2; ++n) _Pragma("unroll") for (int k = 0; k < 2; ++k) dst[n][k] = *(const LAS bf16x8*)(lds + PG8_SB(b, h) + boff + n * 2048 + k * 1024); } while (0)
#define PG8_MMA(ai, bj, At, Bt) do { __builtin_amdgcn_s_setprio(1); _Pragma("unroll") for (int m = 0; m < 4; ++m) _Pragma("unroll") for (int n = 0; n < 2; ++n) _Pragma("unroll") for (int k = 0; k < 2; ++k) \
        acc[ai][bj][m][n] = __builtin_amdgcn_mfma_f32_16x16x32_bf16(Bt[n][k], At[m][k], acc[ai][bj][m][n], 0, 0, 0); __builtin_amdgcn_s_setprio(0); } while (0)
#define PG8_WAIT_V(n) asm volatile("s_waitcnt vmcnt(" #n ")" ::: "memory")
#define PG8_WAIT_L(n) asm volatile("s_waitcnt lgkmcnt(" #n ")" ::: "memory")
#define PG8_BAR __builtin_amdgcn_s_barrier()
#define PG8_SCHED __builtin_amdgcn_sched_barrier(0)
#define PG8_ABASE(uu) ((const char*)g.A + (size_t)((uu).pz >> g.zs) * g.sAhi + (size_t)((uu).pz & zmask) * g.sAlo + (size_t)(uu).pm * tstepA)
#define PG8_BBASE(uu) ((const char*)g.Bt + (size_t)(uu).pz * g.sB + (size_t)(uu).pn * tstepB)
    Unit cur, nxt; int ui = 0;
    if (!S.next(0, cur)) return;
    f32x4 acc[2][2][4][2];
#pragma unroll
    for (int a = 0; a < 2; ++a)
#pragma unroll
        for (int b = 0; b < 2; ++b)
#pragma unroll
            for (int m = 0; m < 4; ++m)
#pragma unroll
                for (int n = 0; n < 2; ++n) acc[a][b][m][n] = (f32x4){0.f, 0.f, 0.f, 0.f};
    bf16x8 At[4][2], B0[2][2], B1[2][2];
    const char* cA = PG8_ABASE(cur); const char* cB = PG8_BBASE(cur);
    PG8_STAGE(PG8_SB(0, 0), cB, voffB); PG8_STAGE(PG8_SB(0, 1), cB + hstepB, voffB); PG8_STAGE(PG8_SA(0, 0), cA, voffA); PG8_STAGE(PG8_SA(0, 1), cA + hstepA, voffA);
    if (wr == 1) PG8_BAR;
    PG8_WAIT_V(2); PG8_BAR;
    PG8_STAGE(PG8_SB(1, 0), cB + kstep, voffB); PG8_STAGE(PG8_SA(1, 0), cA + kstep, voffA); PG8_STAGE(PG8_SB(1, 1), cB + hstepB + kstep, voffB);
    PG8_WAIT_V(6); PG8_BAR;
    for (;;) {
        const bool has_next = S.next(ui + 1, nxt);
        const char* nA = has_next ? PG8_ABASE(nxt) : cA; const char* nB = has_next ? PG8_BBASE(nxt) : cB;
        for (int t = 0; t < nt; t += 2) {
            const bool last = (t == nt - 2);
            const char* a1 = cA + (size_t)(t + 1) * kstep;
            const char* a2 = last ? nA : cA + (size_t)(t + 2) * kstep; const char* b2 = last ? nB : cB + (size_t)(t + 2) * kstep;
            const char* a3 = a2 + kstep; const char* b3 = b2 + kstep;
            PG8_LDB(B0, 0, 0); PG8_LDB(B1, 0, 1); PG8_SCHED; PG8_LDA(At, 0, 0); PG8_STAGE(PG8_SA(1, 1), a1 + hstepA, voffA);
            PG8_WAIT_V(8); PG8_WAIT_L(0); PG8_BAR; PG8_MMA(0, 0, At, B0); PG8_MMA(0, 1, At, B1); PG8_BAR; PG8_SCHED;
            PG8_LDA(At, 0, 1); PG8_STAGE(PG8_SB(0, 0), b2, voffB); PG8_STAGE(PG8_SB(0, 1), b2 + hstepB, voffB); PG8_STAGE(PG8_SA(0, 0), a2, voffA);
            PG8_WAIT_V(8); PG8_WAIT_L(0); PG8_BAR; PG8_MMA(1, 0, At, B0); PG8_MMA(1, 1, At, B1); PG8_BAR; PG8_SCHED;
            PG8_LDB(B0, 1, 0); PG8_LDB(B1, 1, 1); PG8_SCHED; PG8_LDA(At, 1, 0); PG8_STAGE(PG8_SA(0, 1), a2 + hstepA, voffA);
            PG8_WAIT_V(8); PG8_WAIT_L(0); PG8_BAR; PG8_MMA(0, 0, At, B0); PG8_MMA(0, 1, At, B1); PG8_BAR; PG8_SCHED;
            PG8_LDA(At, 1, 1); PG8_STAGE(PG8_SB(1, 0), b3, voffB); PG8_STAGE(PG8_SB(1, 1), b3 + hstepB, voffB); PG8_STAGE(PG8_SA(1, 0), a3, voffA);
            PG8_WAIT_V(8); PG8_WAIT_L(0); PG8_BAR; PG8_MMA(1, 0, At, B0); PG8_MMA(1, 1, At, B1); PG8_BAR; PG8_SCHED;
        }
        if (wr == 0) PG8_BAR;
        { int fr_ = fr, fq_ = fq; asm volatile("" : "+v"(fr_), "+v"(fq_));
          E(acc, cur, wr, wc, fr_, fq_); }
        if (!has_next) break;
#pragma unroll
        for (int a = 0; a < 2; ++a)
#pragma unroll
            for (int b = 0; b < 2; ++b)
#pragma unroll
                for (int m = 0; m < 4; ++m)
#pragma unroll
                    for (int n = 0; n < 2; ++n) acc[a][b][m][n] = (f32x4){0.f, 0.f, 0.f, 0.f};
        cur = nxt; cA = nA; cB = nB; ++ui;
        if (wr == 1) PG8_BAR;
    }
    PG8_WAIT_V(0);
    PG8_BAR;
#undef PG8_SA
#undef PG8_SB
#undef PG8_STAGE
#undef PG8_LDA
#undef PG8_LDB
#undef PG8_MMA
#undef PG8_WAIT_V
#undef PG8_WAIT_L
#undef PG8_BAR
#undef PG8_SCHED
#undef PG8_ABASE
#undef PG8_BBASE
}
}

__device__ __forceinline__ float wave_sum(float v) {
#pragma unroll
    for (int o = 1; o < 64; o <<= 1) v += __shfl_xor(v, o);
    return v;
}
__device__ __forceinline__ unsigned pk2(float lo, float hi) { return pg8::cvt_pk_bf16(lo, hi); }
__device__ __forceinline__ f32x2 cmul(f32x2 a, f32x2 b) { return (f32x2){a.x * b.x - a.y * b.y, a.x * b.y + a.y * b.x}; }

struct Args { const float* in[23]; float* out; unsigned char* ws; int ph_lo, ph_hi; };

__device__ __forceinline__ void transpose_item(const float* W, const float* gk, int K, int N, bf16_t* WT, LAS float* scr, int item, int lane) {
    const int nblk = N / 32, kb = item / nblk, nb = item % nblk, k0 = 64 * kb, n0 = 32 * nb;
#pragma unroll 8
    for (int i = 0; i < 32; ++i) { const int kk = 2 * i + (lane >> 5); float v = __builtin_nontemporal_load(W + (size_t)(k0 + kk) * N + n0 + (lane & 31));   if (gk) v *= gk[k0 + kk]; scr[kk * 33 + (lane & 31)] = v; }
    asm volatile("s_waitcnt lgkmcnt(0)" ::: "memory");
    const int c = lane & 7;
#pragma unroll
    for (int j = 0; j < 4; ++j) { const int n = (lane >> 3) + 8 * j; const LAS float* s = scr + (8 * c) * 33 + n;
        u32x4 o; o.x = pk2(s[0 * 33], s[1 * 33]); o.y = pk2(s[2 * 33], s[3 * 33]); o.z = pk2(s[4 * 33], s[5 * 33]); o.w = pk2(s[6 * 33], s[7 * 33]);
        *(u32x4*)(WT + (size_t)(n0 + n) * K + k0 + 8 * c) = o; }
    asm volatile("s_waitcnt lgkmcnt(0)" ::: "memory");
}

__device__ __forceinline__ void ssm_tables(const Args& a, LAS unsigned char* lds, int l, int g, const int tid) {
    LAS f32x2* sB = (LAS f32x2*)lds;
    LAS f32x2* sC = (LAS f32x2*)(lds + 8192);
    LAS f32x2* sP = (LAS f32x2*)(lds + 16384);
    LAS float* sK = (LAS float*)(lds + 25600);
    const float dt = expf(a.in[10][l * NG + g]);
    const float* lre = a.in[8] + (size_t)(l * NG + g) * NP; const float* lim = a.in[9] + (size_t)(l * NG + g) * NP;
    for (int idx = tid; idx < 17 * 64; idx += 512) { const int tau = idx >> 6, p = idx & 63; const float ar = lre[p] * dt * (float)tau, ai = lim[p] * dt * (float)tau;
        float sn, cs; sincosf(ai, &sn, &cs); const float ex = expf(ar); sP[idx] = (f32x2){ex * cs, ex * sn}; }
    for (int idx = tid; idx < 1024; idx += 512) { const int p = idx >> 4, c = idx & 15; const float ar = lre[p] * dt, ai = lim[p] * dt;
        float sn, cs; sincosf(ai, &sn, &cs); const float sh = sinf(0.5f * ai); const float em1 = expm1f(ar), ex = em1 + 1.0f;
        const float x = em1 * cs - 2.0f * sh * sh, y = ex * sn;
        const float ur = lre[p], ui = lim[p], den = 1.0f / (ur * ur + ui * ui);
        const f32x2 coef = {(x * ur + y * ui) * den, (y * ur - x * ui) * den};
        const size_t bo = ((size_t)(l * NG + g) * NP + p) * 16 + c;
        sB[idx] = cmul(coef, (f32x2){a.in[11][bo], a.in[12][bo]}); }
    for (int idx = tid; idx < 1024; idx += 512) { const size_t co = (size_t)(l * NG + g) * 1024 + idx; sC[idx] = (f32x2){a.in[13][co], a.in[14][co]}; }
    __syncthreads();
    for (int idx = tid; idx < 4096; idx += 512) { const int tau = idx >> 8, c = (idx >> 4) & 15, c2 = idx & 15; float s = 0.f;
        for (int p = 0; p < 64; ++p) { const f32x2 w = cmul(sC[c * 64 + p], sP[tau * 64 + p]); const f32x2 b = sB[p * 16 + c2]; s += w.x * b.x - w.y * b.y; }
        sK[idx] = s; }
    if (tid < 64) {
        f32x2* aux = (f32x2*)(a.ws + WS_AUX); f32x2 v = sP[16 * 64 + tid]; aux[(l * NG + g) * NP + tid] = v;
#pragma unroll
        for (int i = 0; i < 6; ++i) v = cmul(v, v);
        aux[2 * NG * NP + (l * NG + g) * NP + tid] = v;
    }
    __syncthreads();
    bf16_t* Ty = (bf16_t*)(a.ws + WS_W + (size_t)l * WL_SZ + WL_TY) + (size_t)g * 256 * 384;
    for (int v = tid; v < 256 * 48; v += 512) { const int row = v / 48, k0 = (v % 48) * 8, t = row >> 4, c = row & 15; float o[8];
        if (k0 < 256) { const int s = k0 >> 4, c0 = k0 & 15;
#pragma unroll
            for (int e = 0; e < 8; ++e) o[e] = (s <= t) ? sK[((t - s) * 16 + c) * 16 + c0 + e] : 0.f;
        } else { const int kk = k0 - 256;
#pragma unroll
            for (int e = 0; e < 8; ++e) { const int p = (kk + e) >> 1; const f32x2 w = cmul(sC[c * 64 + p], sP[(t + 1) * 64 + p]); o[e] = (e & 1) ? -w.y : w.x; }
        }
        u32x4 w; w.x = pk2(o[0], o[1]); w.y = pk2(o[2], o[3]); w.z = pk2(o[4], o[5]); w.w = pk2(o[6], o[7]);
        *(u32x4*)(Ty + (size_t)row * 384 + k0) = w; }
    const int gi = g & 1;
    bf16_t* We = (bf16_t*)(a.ws + WS_W + (size_t)l * WL_SZ + WL_WE) + ((size_t)(g >> 1) * 256 + gi * 128) * ABP;
    for (int v = tid; v < 128 * 96; v += 512) { const int rr = v / 96, k0 = (v % 96) * 8, p = rr >> 1, ri = rr & 1; float o[8];
        const int kq = k0 - gi * 384;
        if (kq >= 0 && kq < 256) { const int s = kq >> 4, c0 = kq & 15;
#pragma unroll
            for (int e = 0; e < 8; ++e) { const f32x2 w = cmul(sP[(15 - s) * 64 + p], sB[p * 16 + c0 + e]); o[e] = ri ? w.y : w.x; }
        } else {
#pragma unroll
            for (int e = 0; e < 8; ++e) o[e] = 0.f;
        }
        u32x4 w; w.x = pk2(o[0], o[1]); w.y = pk2(o[2], o[3]); w.z = pk2(o[4], o[5]); w.w = pk2(o[6], o[7]);
        *(u32x4*)(We + (size_t)rr * ABP + k0) = w; }
    __syncthreads();
}

__device__ __forceinline__ void wcomb_item(const Args& a, LAS unsigned char* lds, int l, int kg, int ntile, const int tid) {
    LAS float* sAt = (LAS float*)lds;
    LAS float* sBm = (LAS float*)(lds + 128 * 132 * 4);
    const float* wp = a.in[17] + (size_t)(l * 4 + kg) * 128 * 128; const float* sc = a.in[18] + l * WB + kg * 128;
    for (int idx = tid; idx < 16384; idx += 512) { const int c = idx >> 7, d = idx & 127; sAt[d * 132 + c] = wp[idx] * sc[d]; }
    const float* wo = a.in[19] + (size_t)l * DM * DM + (size_t)(512 + kg * 128) * DM + ntile * 64;
    for (int idx = tid; idx < 8192; idx += 512) { const int d = idx >> 6, n = idx & 63; sBm[idx] = wo[(size_t)d * DM + n]; }
    __syncthreads();
    const int n = tid >> 3, cs = (tid & 7) * 16;
    f32x4 acc0 = {0.f, 0.f, 0.f, 0.f}, acc1 = acc0, acc2 = acc0, acc3 = acc0;
    for (int d = 0; d < 128; ++d) { const float b = sBm[d * 64 + n]; const LAS f32x4* ap = (const LAS f32x4*)(sAt + d * 132 + cs);
        acc0 += ap[0] * b; acc1 += ap[1] * b; acc2 += ap[2] * b; acc3 += ap[3] * b; }
    bf16_t* dst = (bf16_t*)(a.ws + WS_W + (size_t)l * WL_SZ + WL_OUT) + (size_t)(ntile * 64 + n) * DM + 512 + kg * 128 + cs;
    *(u32x4*)dst = pg8::pack8(acc0, acc1); *(u32x4*)(dst + 8) = pg8::pack8(acc2, acc3);
    __syncthreads();
}

__device__ __forceinline__ void phase_prologue(const Args& a, LAS unsigned char* lds, int G, const int bid, const int tid) {
    const int lane = tid & 63, wave = tid >> 6;
    const int gw = bid * 8 + wave, NGW = G * 8;
    LAS float* scr = (LAS float*)(lds + wave * 16384);
    for (int it = gw; it < 16 * 32; it += NGW) transpose_item(a.in[7], a.in[5], DM, DM, (bf16_t*)(a.ws + WS_W + WL_IN), scr, it, lane);
    const int gt = bid * 512 + tid, NGT = G * 512;
    if (bid == 0) for (int i = tid; i < 3456 + 256; i += 512) ((unsigned*)(a.ws + WS_BAR))[i] = 0u;
    float* rsq = (float*)(a.ws + WS_RSQ);
    for (int i = gt; i < 4 * M; i += NGT) rsq[M + i] = 0.f;
    bf16_t* XB = (bf16_t*)(a.ws + WS_XB);
    for (int q = gw; q < M / 4; q += NGW) {
        f32x4 v[4][4];
#pragma unroll
        for (int rr = 0; rr < 4; ++rr) { const int m = 4 * q + rr; const float* src = m < MP ? a.in[0] + (size_t)m * DM : a.in[1] + (size_t)(m - MP) * DM;
#pragma unroll
            for (int j = 0; j < 4; ++j) v[rr][j] = __builtin_nontemporal_load(((const f32x4*)src) + lane + 64 * j); }
#pragma unroll
        for (int rr = 0; rr < 4; ++rr) { const int m = 4 * q + rr; float s = 0.f;
#pragma unroll
            for (int j = 0; j < 4; ++j) s += (v[rr][j].x * v[rr][j].x + v[rr][j].y * v[rr][j].y) + (v[rr][j].z * v[rr][j].z + v[rr][j].w * v[rr][j].w);
            s = wave_sum(s);
#pragma unroll
            for (int j = 0; j < 4; ++j) ((u32x2*)(XB + (size_t)m * DM))[lane + 64 * j] = (u32x2){pk2(v[rr][j].x, v[rr][j].y), pk2(v[rr][j].z, v[rr][j].w)};
            if (lane == 0) rsq[m] = s; }
    }
}
__device__ __forceinline__ void phase_prologue_rest(const Args& a, LAS unsigned char* lds, int G, const int bid, const int tid) {
    const int lane = tid & 63, wave = tid >> 6;
    const int nlead = (G == 256) ? 32 : 0;
    if (bid < nlead) return;
    const int vb = bid - nlead, GB = G - nlead;
    for (int item = vb; item < 2 * NG; item += GB) ssm_tables(a, lds, item / NG, item % NG, tid);
    for (int item = (vb + GB - 64 % GB) % GB; item < 2 * 4 * 16; item += GB) wcomb_item(a, lds, item >> 6, (item >> 4) & 3, item & 15, tid);
    const int ntab = (GB >= 128) ? 64 : 0;
    if (vb < ntab) return;
    const int gw = (vb - ntab) * 8 + wave, NGW = (GB - ntab) * 8;
    LAS float* scr = (LAS float*)(lds + wave * 16384);
    constexpr int I_IN = 16 * 32, I_GLU = 8 * 16, I_OUT = 8 * 32, I_1 = 16 * 128, I_2 = 64 * 32, I_L = I_IN + I_GLU + I_OUT + I_1 + I_2;
    for (int it = gw + I_IN; it < 2 * I_L; it += NGW) {
        const int l = it / I_L; int r = it - l * I_L; unsigned char* wl = a.ws + WS_W + (size_t)l * WL_SZ;
        if (r < I_IN) { transpose_item(a.in[7] + (size_t)l * DM * DM, a.in[5] + l * DM, DM, DM, (bf16_t*)(wl + WL_IN), scr, r, lane); continue; } r -= I_IN;
        if (r < I_GLU) { transpose_item(a.in[16] + (size_t)l * WA * WA, nullptr, WA, WA, (bf16_t*)(wl + WL_GLU), scr, r, lane); continue; } r -= I_GLU;
        if (r < I_OUT) { transpose_item(a.in[19] + (size_t)l * DM * DM, nullptr, DM, DM, (bf16_t*)(wl + WL_OUT), scr, r, lane); continue; } r -= I_OUT;
        if (r < I_1) { transpose_item(a.in[20] + (size_t)l * DM * FF, a.in[6] + l * DM, DM, FF, (bf16_t*)(wl + WL_W1), scr, r, lane); continue; } r -= I_1;
        transpose_item(a.in[21] + (size_t)l * FF * DM, nullptr, FF, DM, (bf16_t*)(wl + WL_W2), scr, r, lane);
    }
}

__device__ __forceinline__ void phase_diff(const Args& a, int l, int G, const int bid, const int tid) {
    const int lane = tid & 63, wave = tid >> 6;
    const int nskip = (G == 256) ? 16 : 0;
    if (bid < nskip) return;
    const int gw = (bid - nskip) * 8 + wave, NGW = (G - nskip) * 8;
    const bf16_t* UB = (const bf16_t*)(a.ws + WS_UB); bf16_t* MIXB = (bf16_t*)(a.ws + WS_MIX) + WA;
    const int n0 = lane * 8, w = 2 << (lane >> 4);
    for (int r = gw; r < M / 32; r += NGW) {
        const int m0 = r * 32; const bool prm = m0 < MP;
        int seq, t0, L, mseq; const float* hist; float* hout;
        if (prm) { seq = m0 / PL; t0 = m0 % PL; L = PL; mseq = seq * PL; hist = nullptr; hout = a.out + O_PPOOL + (size_t)(l * PB_ + seq) * 15 * WB; }
        else { const int ms = m0 - MP; seq = ms / SL; t0 = ms % SL; L = SL; mseq = MP + seq * SL; hist = a.in[4] + (size_t)(l * SB_ + seq) * 15 * WB; hout = a.out + O_SPOOL + (size_t)(l * SB_ + seq) * 15 * WB; }
        float ws_[8];
#pragma unroll
        for (int e = 0; e < 8; ++e) ws_[e] = 0.f;
#define FETCH8(dst, tt) do { const int _t = (tt); if (_t >= 0) { const u32x4 _w = *(const u32x4*)(UB + (size_t)(mseq + _t) * WB + n0); \
            dst[0] = pg8::bf_lo(_w.x); dst[1] = pg8::bf_hi(_w.x); dst[2] = pg8::bf_lo(_w.y); dst[3] = pg8::bf_hi(_w.y); dst[4] = pg8::bf_lo(_w.z); dst[5] = pg8::bf_hi(_w.z); dst[6] = pg8::bf_lo(_w.w); dst[7] = pg8::bf_hi(_w.w); } \
          else if (hist) { const f32x4 _a = *(const f32x4*)(hist + (size_t)(15 + _t) * WB + n0), _b = *(const f32x4*)(hist + (size_t)(15 + _t) * WB + n0 + 4); \
            dst[0] = _a.x; dst[1] = _a.y; dst[2] = _a.z; dst[3] = _a.w; dst[4] = _b.x; dst[5] = _b.y; dst[6] = _b.z; dst[7] = _b.w; } \
          else { _Pragma("unroll") for (int _e = 0; _e < 8; ++_e) dst[_e] = 0.f; } } while (0)
        if (t0 >= 15) {
#define UNPK8(dst, _w) do { dst[0] = pg8::bf_lo(_w.x); dst[1] = pg8::bf_hi(_w.x); dst[2] = pg8::bf_lo(_w.y); dst[3] = pg8::bf_hi(_w.y); dst[4] = pg8::bf_lo(_w.z); dst[5] = pg8::bf_hi(_w.z); dst[6] = pg8::bf_lo(_w.w); dst[7] = pg8::bf_hi(_w.w); } while (0)
            const bf16_t* ub = UB + (size_t)(mseq + t0) * WB + n0;
            { u32x4 pre[15];
#pragma unroll
              for (int i = 1; i < 16; ++i) pre[i - 1] = *(const u32x4*)(ub - (size_t)i * WB);
#pragma unroll
              for (int i = 1; i < 16; ++i) { float f[8]; UNPK8(f, pre[i - 1]);
#pragma unroll
                  for (int e = 0; e < 8; ++e) ws_[e] += (i < w) ? f[e] : 0.f; } }
            const float inv = 1.0f / (float)w;
            for (int i0 = 0; i0 < 32; i0 += 4) {
                u32x4 cw[4], ow[4];
#pragma unroll
                for (int k = 0; k < 4; ++k) { cw[k] = *(const u32x4*)(ub + (size_t)(i0 + k) * WB); ow[k] = *(const u32x4*)(ub + (size_t)(i0 + k - w + 1) * WB); }
#pragma unroll
                for (int k = 0; k < 4; ++k) {
                    const int t = t0 + i0 + k; float cur[8], old[8], o[8];
                    UNPK8(cur, cw[k]); UNPK8(old, ow[k]);
#pragma unroll
                    for (int e = 0; e < 8; ++e) { ws_[e] += cur[e]; o[e] = ws_[e] * inv - cur[e]; ws_[e] -= old[e]; }
                    u32x4 pw; pw.x = pk2(o[0], o[1]); pw.y = pk2(o[2], o[3]); pw.z = pk2(o[4], o[5]); pw.w = pk2(o[6], o[7]);
                    *(u32x4*)(MIXB + (size_t)(mseq + t) * DM + n0) = pw;
                    if (t >= L - 15) { float* hp = hout + (size_t)(t - (L - 15)) * WB + n0; *(f32x4*)hp = (f32x4){cur[0], cur[1], cur[2], cur[3]}; *(f32x4*)(hp + 4) = (f32x4){cur[4], cur[5], cur[6], cur[7]}; }
                }
            }
#undef UNPK8
            continue;
        }
        for (int i = 1; i < w; ++i) { float f[8]; FETCH8(f, t0 - i);
#pragma unroll
            for (int e = 0; e < 8; ++e) ws_[e] += f[e]; }
        for (int i = 0; i < 32; ++i) {
            const int t = t0 + i; float cur[8], old[8], o[8];
            FETCH8(cur, t); FETCH8(old, t - w + 1);
            const float inv = 1.0f / (float)(prm ? min(t + 1, w) : w);
#pragma unroll
            for (int e = 0; e < 8; ++e) { ws_[e] += cur[e]; o[e] = ws_[e] * inv - cur[e]; ws_[e] -= old[e]; }
            u32x4 pw; pw.x = pk2(o[0], o[1]); pw.y = pk2(o[2], o[3]); pw.z = pk2(o[4], o[5]); pw.w = pk2(o[6], o[7]);
            *(u32x4*)(MIXB + (size_t)(mseq + t) * DM + n0) = pw;
            if (t >= L - 15) { float* hp = hout + (size_t)(t - (L - 15)) * WB + n0; *(f32x4*)hp = (f32x4){cur[0], cur[1], cur[2], cur[3]}; *(f32x4*)(hp + 4) = (f32x4){cur[4], cur[5], cur[6], cur[7]}; }
        }
#undef FETCH8
    }
}

__device__ __forceinline__ void phase_scan(const Args& a, LAS unsigned char* lds, int l, int G, const int bid, const int tid) {
    const int p = tid & 63, wave = tid >> 6;
    const bf16_t* E = (const bf16_t*)(a.ws + WS_E); bf16_t* AB = (bf16_t*)(a.ws + WS_AB);
    const f32x2* aux = (const f32x2*)(a.ws + WS_AUX);
    LAS f32x2* sL = (LAS f32x2*)lds;
    for (int pair = bid; pair < PB_ * NG; pair += G) {
        const int seq = pair / NG, g = pair % NG;
        const f32x2 lam = aux[(l * NG + g) * NP + p], lseg = aux[2 * NG * NP + (l * NG + g) * NP + p];
        const int j0 = seq * (PL / TS) + wave * 64;
        const unsigned* ep = (const unsigned*)(E + ((size_t)g * NJ + j0) * 128) + p;
        f32x2 h = {0.f, 0.f};
        for (int i0 = 0; i0 < 64; i0 += 16) { unsigned eb[16];
#pragma unroll
            for (int k = 0; k < 16; ++k) eb[k] = ep[(size_t)(i0 + k) * 64];
#pragma unroll
            for (int k = 0; k < 16; ++k) h = cmul(lam, h) + (f32x2){pg8::bf_lo(eb[k]), pg8::bf_hi(eb[k])}; }
        sL[wave * 64 + p] = h;
        __syncthreads();
        f32x2 c = {0.f, 0.f};
        for (int w2 = 0; w2 < wave; ++w2) c = cmul(lseg, c) + sL[w2 * 64 + p];
        h = c;
        unsigned* hp = (unsigned*)(AB + ((size_t)((g >> 1) * NJP + j0) * ABP + (g & 1) * 384 + 256 + 2 * p));
        for (int i0 = 0; i0 < 64; i0 += 16) { unsigned eb[16];
#pragma unroll
            for (int k = 0; k < 16; ++k) eb[k] = ep[(size_t)(i0 + k) * 64];
#pragma unroll
            for (int k = 0; k < 16; ++k) { hp[(size_t)(i0 + k) * (ABP / 2)] = pk2(h.x, h.y); h = cmul(lam, h) + (f32x2){pg8::bf_lo(eb[k]), pg8::bf_hi(eb[k])}; } }
        if (wave == 7) { a.out[O_PRE + (size_t)((l * PB_ + seq) * NG + g) * NP + p] = h.x; a.out[O_PIM + (size_t)((l * PB_ + seq) * NG + g) * NP + p] = h.y; }
        __syncthreads();
    }
    for (int sp = bid * 8 + wave; sp < SB_ * NG; sp += G * 8) {
        const int seq = sp / NG, g = sp % NG;
        const f32x2 lam = aux[(l * NG + g) * NP + p];
        const int j0 = MP / TS + seq * (SL / TS);
        const unsigned* ep = (const unsigned*)(E + ((size_t)g * NJ + j0) * 128) + p;
        const size_t so = (size_t)((l * SB_ + seq) * NG + g) * NP + p;
        f32x2 h = {a.in[2][so], a.in[3][so]};
        unsigned* hp = (unsigned*)(AB + ((size_t)((g >> 1) * NJP + j0) * ABP + (g & 1) * 384 + 256 + 2 * p));
        unsigned es[SL / TS];
#pragma unroll
        for (int i = 0; i < SL / TS; ++i) es[i] = ep[(size_t)i * 64];
#pragma unroll
        for (int i = 0; i < SL / TS; ++i) { hp[(size_t)i * (ABP / 2)] = pk2(h.x, h.y); h = cmul(lam, h) + (f32x2){pg8::bf_lo(es[i]), pg8::bf_hi(es[i])}; }
        a.out[O_SRE + so] = h.x; a.out[O_SIM + so] = h.y;
    }
}

__device__ __forceinline__ void phase_final(const Args& a, int G, const int bid, const int tid) {
    const int lane = tid & 63, wave = tid >> 6;
    const int gw = bid * 8 + wave, NGW = G * 8;
    const float* rsq = (const float*)(a.ws + WS_RSQ) + 4 * (size_t)M; const float* rs3 = (const float*)(a.ws + WS_RSQ) + 3 * (size_t)M;
    f32x4 gv[4];
#pragma unroll
    for (int j = 0; j < 4; ++j) gv[j] = ((const f32x4*)a.in[22])[lane + 64 * j];
    const bf16_t* XB = (const bf16_t*)(a.ws + WS_XB); const bf16_t* SL = (const bf16_t*)(a.ws + WS_SLAB);
    for (int q = gw; q < MP / 4; q += NGW) {
        u32x2 w[4][4]; float rq[4];
#pragma unroll
        for (int rr = 0; rr < 4; ++rr) { const int m = 4 * q + rr; rq[rr] = rsq[m];
#pragma unroll
            for (int j = 0; j < 4; ++j) w[rr][j] = __builtin_nontemporal_load(((const u32x2*)(XB + (size_t)m * DM)) + lane + 64 * j); }
#pragma unroll
        for (int rr = 0; rr < 4; ++rr) { const int m = 4 * q + rr; const float r = __builtin_amdgcn_rsqf(rq[rr] * (1.0f / DM) + EPS);
            f32x4* yr = (f32x4*)(a.out + O_Y + (size_t)m * DM);
#pragma unroll
            for (int j = 0; j < 4; ++j) { const f32x4 v = {pg8::bf_lo(w[rr][j].x), pg8::bf_hi(w[rr][j].x), pg8::bf_lo(w[rr][j].y), pg8::bf_hi(w[rr][j].y)}; __builtin_nontemporal_store(v * r * gv[j], yr + lane + 64 * j); } }
    }
    for (int m = MP + gw; m < M; m += NGW) {
        f32x4 v[4];
#pragma unroll
        for (int j = 0; j < 4; ++j) { const u32x2 w = ((const u32x2*)(XB + (size_t)m * DM))[lane + 64 * j]; v[j] = (f32x4){pg8::bf_lo(w.x), pg8::bf_hi(w.x), pg8::bf_lo(w.y), pg8::bf_hi(w.y)}; }
        float ss = 0.f; const float r2s = __builtin_amdgcn_rcpf(rs3[m] * (1.0f / DM) + EPS);
#pragma unroll
        for (int j = 0; j < 4; ++j) {
            f32x4 p = {0.f, 0.f, 0.f, 0.f};
#pragma unroll
            for (int z = 0; z < 8; ++z) { const u32x2 sw = ((const u32x2*)(SL + ((size_t)z * MS + (m - MP)) * DM))[lane + 64 * j]; p += (f32x4){pg8::bf_lo(sw.x), pg8::bf_hi(sw.x), pg8::bf_lo(sw.y), pg8::bf_hi(sw.y)}; }
            v[j] += p * r2s;
            ss += (v[j].x * v[j].x + v[j].y * v[j].y) + (v[j].z * v[j].z + v[j].w * v[j].w); }
        const float r = __builtin_amdgcn_rsqf(wave_sum(ss) * (1.0f / DM) + EPS);
        f32x4* yr = (f32x4*)(a.out + O_Y + (size_t)m * DM);
#pragma unroll
        for (int j = 0; j < 4; ++j) __builtin_nontemporal_store(v[j] * r * gv[j], yr + lane + 64 * j);
    }
}

__device__ __forceinline__ void phase_sample_finalize(const Args& a, unsigned char* ws, int G, const int bid, const int tid) {
    const int lane = tid & 63, wave = tid >> 6;
    bf16_t* XB = (bf16_t*)(ws + WS_XB); const bf16_t* SL = (const bf16_t*)(ws + WS_SLAB); float* rsq = (float*)(ws + WS_RSQ) + 2 * (size_t)M; const float* rs1 = (const float*)(ws + WS_RSQ) + (size_t)M;
    for (int r = bid * 8 + wave; r < MS; r += G * 8) {
        const int m = MP + r; float ss = 0.f; u32x2 o[4];
        const float r2 = __builtin_amdgcn_rcpf(rs1[m] * (1.0f / DM) + EPS);
#pragma unroll
        for (int j = 0; j < 4; ++j) { const u32x2 w = ((const u32x2*)(XB + (size_t)m * DM))[lane + 64 * j]; f32x4 v = {pg8::bf_lo(w.x), pg8::bf_hi(w.x), pg8::bf_lo(w.y), pg8::bf_hi(w.y)};
            f32x4 p = {0.f, 0.f, 0.f, 0.f};
#pragma unroll
            for (int z = 0; z < 8; ++z) { const u32x2 sw = ((const u32x2*)(SL + ((size_t)z * MS + r) * DM))[lane + 64 * j]; p += (f32x4){pg8::bf_lo(sw.x), pg8::bf_hi(sw.x), pg8::bf_lo(sw.y), pg8::bf_hi(sw.y)}; }
            v += p * r2;
            ss += (v.x * v.x + v.y * v.y) + (v.z * v.z + v.w * v.w); o[j] = (u32x2){pk2(v.x, v.y), pk2(v.z, v.w)}; }
#pragma unroll
        for (int j = 0; j < 4; ++j) ((u32x2*)(XB + (size_t)m * DM))[lane + 64 * j] = o[j];
        ss = wave_sum(ss);
        if (lane == 0) rsq[m] = ss;
    }
}

#define XB_TMO      128
#define XB_XCNT(j)  (256  + 64 * (j))
#define XB_XSUB(j)  (1280 + 64 * (j))
#define XB_XGEN(j)  (2304 + 64 * (j))
#define XB_TOP      3328
#define XB_TOPGEN   3392
#define XCD_BAR_WORDS 3456
#define XB_SPIN_CAP (1u << 18)
__device__ __forceinline__ unsigned xb_ld(unsigned* p)              { return __hip_atomic_load(p, __ATOMIC_RELAXED, __HIP_MEMORY_SCOPE_AGENT); }
__device__ __forceinline__ unsigned xb_add(unsigned* p, unsigned v) { return __hip_atomic_fetch_add(p, v, __ATOMIC_RELAXED, __HIP_MEMORY_SCOPE_AGENT); }
__device__ __forceinline__ unsigned xb_xcc_id() { return (unsigned)__builtin_amdgcn_s_getreg((3 << 11) | 20) & 0xFu; }
#define XB_SPIN(cond, bar) do { unsigned _sp = 0; while (cond) { __builtin_amdgcn_s_sleep(1); \
    if ((++_sp & 255u) == 0u) { if (xb_ld(&(bar)[XB_TMO])) break; if (_sp > XB_SPIN_CAP) { atomicAdd(&(bar)[XB_TMO], 1u); break; } } } } while (0)
struct XcdBarrier { unsigned* bar; unsigned x; volatile LAS unsigned* st; };
__device__ __forceinline__ XcdBarrier xcd_barrier_post(unsigned* bar, volatile LAS unsigned* st) {
    XcdBarrier b; b.bar = bar; b.x = xb_xcc_id(); b.st = st;
    if (threadIdx.x == 0) (void)xb_add(&bar[XB_XCNT(b.x)], 1u);
    return b;
}
__device__ __forceinline__ void xcd_barrier_complete(unsigned* bar, unsigned x, unsigned& nloc, unsigned& nx) {
    const unsigned G = gridDim.x * gridDim.y * gridDim.z;
    unsigned sum, cnt, mine, sp = 0u;
    for (;;) {
        sum = 0u; cnt = 0u; mine = 0u;
#pragma unroll
        for (unsigned j = 0; j < 16; ++j) { const unsigned c = xb_ld(&bar[XB_XCNT(j)]); sum += c; cnt += (c > 0u) ? 1u : 0u; mine = (j == x) ? c : mine; }
        if (sum == G) break;
        __builtin_amdgcn_s_sleep(1);
        if ((++sp & 255u) == 0u) { if (xb_ld(&bar[XB_TMO])) break; if (sp > XB_SPIN_CAP) { atomicAdd(&bar[XB_TMO], 1u); break; } }
    }
    nloc = mine > 0u ? mine : 1u; nx = cnt > 0u ? cnt : 1u;
}
__device__ __forceinline__ void xcd_barrier(const XcdBarrier& b) {
    asm volatile("s_waitcnt vmcnt(0)" ::: "memory");
    __syncthreads();
    if (threadIdx.x == 0) {
        unsigned* bar = b.bar;
        __builtin_amdgcn_s_waitcnt(0);
        unsigned nloc = b.st[0], nx = b.st[1];
        if (nloc == 0u) { xcd_barrier_complete(bar, b.x, nloc, nx); b.st[0] = nloc; b.st[1] = nx; }
        const unsigned old = xb_add(&bar[XB_XSUB(b.x)], 1u);
        const unsigned gen = old / nloc;
        if (old + 1u == (gen + 1u) * nloc) {
            __builtin_amdgcn_fence(__ATOMIC_RELEASE, "agent");
            asm volatile("s_waitcnt vmcnt(0)" ::: "memory");
            const unsigned og = xb_add(&bar[XB_TOP], 1u);
            const unsigned tg = og / nx;
            if (og + 1u == (tg + 1u) * nx) xb_add(&bar[XB_TOPGEN], 1u);
            else XB_SPIN(xb_ld(&bar[XB_TOPGEN]) == tg, bar);
            __builtin_amdgcn_fence(__ATOMIC_ACQUIRE, "agent");
            xb_add(&bar[XB_XGEN(b.x)], 1u);
            asm volatile("s_waitcnt vmcnt(0)" ::: "memory");
        } else {
            XB_SPIN(xb_ld(&bar[XB_XGEN(b.x)]) == gen, bar);
            __builtin_amdgcn_fence(__ATOMIC_ACQUIRE, "agent");
            asm volatile("s_waitcnt vmcnt(0)" ::: "memory");
        }
    }
    __syncthreads();
}

__device__ __forceinline__ void handoff_publish(unsigned* cnt) {
    if (threadIdx.x == 0) { __builtin_amdgcn_fence(__ATOMIC_RELEASE, "agent"); asm volatile("s_waitcnt vmcnt(0)" ::: "memory"); (void)xb_add(cnt, 1u); }
}
__device__ __forceinline__ void handoff_wait(unsigned* cnt, unsigned want, unsigned* tmo) {
    if (threadIdx.x == 0) { XB_SPIN(xb_ld(cnt) < want, tmo - XB_TMO); __builtin_amdgcn_fence(__ATOMIC_ACQUIRE, "agent"); asm volatile("s_waitcnt vmcnt(0)" ::: "memory"); }
    __syncthreads();
}

__global__ void __launch_bounds__(512, 2) fwd_kernel(Args a) {
    extern __shared__ __attribute__((aligned(16))) unsigned char lds_raw[];
    LAS unsigned char* lds = (LAS unsigned char*)lds_raw;
    const int G = gridDim.x;
    volatile LAS unsigned* bst = (volatile LAS unsigned*)(lds + 131072 + 64);
    if (threadIdx.x < 2) bst[threadIdx.x] = 0u;
    __syncthreads();
    XcdBarrier bar; bar.bar = (unsigned*)(a.ws + WS_BAR); bar.x = 0; bar.st = bst;
#define RELAUNDER() do { size_t wz_ = 0; asm volatile("" : "+s"(wz_), "+v"(tid)); ws = a.ws + wz_; rsq = (float*)(ws + WS_RSQ); XB = (bf16_t*)(ws + WS_XB); AB = (bf16_t*)(ws + WS_AB); Z = (bf16_t*)(ws + WS_Z); MIX = (bf16_t*)(ws + WS_MIX); H = (bf16_t*)(ws + WS_H); wl = ws + WS_W + (size_t)l * WL_SZ; } while (0)
    for (int ph = a.ph_lo; ph < a.ph_hi; ++ph) {
        int tid = threadIdx.x, cidx = blockIdx.x;
        size_t wz = 0;
        asm volatile("" : "+s"(wz), "+v"(tid), "+v"(cidx));
        unsigned char* ws = a.ws + wz;
        cidx = __builtin_amdgcn_readfirstlane(cidx);
        float* rsq = (float*)(ws + WS_RSQ);
        bf16_t* XB = (bf16_t*)(ws + WS_XB); bf16_t* UB = (bf16_t*)(ws + WS_UB); bf16_t* AB = (bf16_t*)(ws + WS_AB);
        bf16_t* Eb = (bf16_t*)(ws + WS_E); bf16_t* Z = (bf16_t*)(ws + WS_Z); bf16_t* MIX = (bf16_t*)(ws + WS_MIX); bf16_t* H = (bf16_t*)(ws + WS_H);
        if (ph == 0) phase_prologue(a, lds, G, cidx, tid);
        else if (ph == NPH - 1) phase_final(a, G, cidx, tid);
        else if (ph == 9) phase_sample_finalize(a, ws, G, cidx, tid);
        else {
            const int l = ph > 9 ? 1 : 0, k = ph > 9 ? ph - 10 : ph - 1;
            const unsigned char* wl = ws + WS_W + (size_t)l * WL_SZ;
            if (k == 0) {
                pg8::Gemm g{XB, (const bf16_t*)(wl + WL_IN), DM, DM, DM, M / 256, DM / 256, 1, 0, 0, 0, 0};
                pg8::EpiIn E{rsq + (size_t)(2 * l) * M, AB, UB};
                pg8::gemm_phase(lds, g, G, cidx, tid, E);
                if (l == 0) phase_prologue_rest(a, lds, G, cidx, tid);
            } else if (k == 1) {
                pg8::Gemm g{AB, (const bf16_t*)(wl + WL_WE), ABP, ABP, ABP, NJP / 256, 1, 16, 0, (size_t)NJP * ABP * 2, 0, (size_t)256 * ABP * 2};
                pg8::EpiE E{Eb};
                pg8::gemm_phase(lds, g, G, cidx, tid, E);
                phase_diff(a, l, G, cidx, tid);
            } else if (k == 2) phase_scan(a, lds, l, G, cidx, tid);
            else if (k == 3) {
                unsigned* hcnt = (unsigned*)(a.ws + WS_BAR) + 3456 + 64 * (2 + l);
                { pg8::Gemm g{AB + (size_t)16 * 256 * ABP, (const bf16_t*)(wl + WL_TY), ABP, 384, 384, 1, 1, 32, 1, (size_t)NJP * ABP * 2, (size_t)384 * 2, (size_t)256 * 384 * 2};
                  pg8::EpiY<16 * 256> E{AB, a.in[15] + l * WA, Z};
                  pg8::gemm_phase(lds, g, G, cidx, tid, E);
                  if (cidx < 32) handoff_publish(hcnt); }
                RELAUNDER();
                { pg8::Gemm g{AB, (const bf16_t*)(wl + WL_TY), ABP, 384, 384, 16, 1, 32, 1, (size_t)NJP * ABP * 2, (size_t)384 * 2, (size_t)256 * 384 * 2};
                  pg8::EpiY<0> E{AB, a.in[15] + l * WA, Z};
                  pg8::gemm_phase(lds, g, G, cidx, tid, E); }
                RELAUNDER();
                { const int c3 = (cidx + G - 32) % G;
                  if (c3 < (MS / 256) * (WA / 256)) handoff_wait(hcnt, 32u, (unsigned*)(a.ws + WS_BAR) + XB_TMO);
                  pg8::Gemm g{Z + (size_t)MP * WA, (const bf16_t*)(wl + WL_GLU), WA, WA, WA, MS / 256, WA / 256, 1, 0, 0, 0, 0};
                  pg8::EpiGlu E{Z + (size_t)MP * WA, MIX + (size_t)MP * DM}; pg8::gemm_phase(lds, g, G, c3, tid, E); }
            } else if (k == 4) {
                pg8::Gemm g{Z, (const bf16_t*)(wl + WL_GLU), WA, WA, WA, MP / 256, WA / 256, 1, 0, 0, 0, 0};
                pg8::EpiGlu E{Z, MIX}; pg8::gemm_phase(lds, g, G, cidx, tid, E);
            } else if (k == 5) {
                unsigned* hcnt = (unsigned*)(a.ws + WS_BAR) + 3456 + 64 * l;
                { pg8::Gemm g{MIX + (size_t)MP * DM, (const bf16_t*)(wl + WL_OUT), DM, DM, DM, MS / 256, DM / 256, 1, 0, 0, 0, 0};
                  pg8::EpiRes<false> E{XB + (size_t)MP * DM, rsq + (size_t)(2 * l + 1) * M + MP, nullptr};
                  pg8::gemm_phase(lds, g, G, cidx, tid, E);
                  if (cidx < (MS / 256) * (DM / 256)) handoff_publish(hcnt); }
                { pg8::Gemm g{MIX, (const bf16_t*)(wl + WL_OUT), DM, DM, DM, MP / 256, DM / 256, 1, 0, 0, 0, 0};
                  pg8::EpiRes<false> E{XB, rsq + (size_t)(2 * l + 1) * M, nullptr};
                  pg8::gemm_phase(lds, g, G, cidx, tid, E); }
                { const int c3 = (cidx + G - 32) % G;
                  if (c3 < (MS / 256) * (FF / 256)) handoff_wait(hcnt, (MS / 256) * (DM / 256), (unsigned*)(a.ws + WS_BAR) + XB_TMO);
                  pg8::Gemm g{XB + (size_t)MP * DM, (const bf16_t*)(wl + WL_W1), DM, DM, DM, MS / 256, FF / 256, 1, 0, 0, 0, 0};
                  pg8::EpiFF1 E{H + (size_t)MP * FF};
                  pg8::gemm_phase(lds, g, G, c3, tid, E); }
            } else if (k == 6) {
                pg8::Gemm g{XB, (const bf16_t*)(wl + WL_W1), DM, DM, DM, MP / 256, FF / 256, 1, 0, 0, 0, 0};
                pg8::EpiFF1 E{H};
                pg8::gemm_phase(lds, g, G, cidx, tid, E);
            } else {
                { pg8::Gemm g{H, (const bf16_t*)(wl + WL_W2), FF, FF, FF, MP / 256, DM / 256, 1, 0, 0, 0, 0};
                  pg8::EpiRes<true> E{XB, rsq + (size_t)(2 * l + 2) * M, rsq + (size_t)(2 * l + 1) * M};
                  pg8::gemm_phase(lds, g, G, cidx, tid, E); }
                { pg8::Gemm g{H + (size_t)MP * FF, (const bf16_t*)(wl + WL_W2), FF, FF, 512, MS / 256, DM / 256, 8, 0, (size_t)512 * 2, 0, (size_t)512 * 2};
                  pg8::EpiSlab E{(bf16_t*)(ws + WS_SLAB)};
                  pg8::gemm_phase(lds, g, G, cidx, tid, E); }
            }
        }
        if (ph + 1 < a.ph_hi) {
            if (ph == a.ph_lo) { cg::this_grid().sync(); bar = xcd_barrier_post((unsigned*)(a.ws + WS_BAR), bst); }
            else xcd_barrier(bar);
        }
    }
}

extern "C" void kernel_launch(void* const* d_in, const int* in_sizes, int n_in, void* d_out, int out_size, void* d_ws, size_t ws_size, hipStream_t stream) {
    static int grid = 0;
    if (grid == 0) {
        if (n_in != 23 || ws_size < WS_END) { fprintf(stderr, "kernel_launch: n_in %d ws %zu (need %zu)\n", n_in, ws_size, (size_t)WS_END); grid = -1; return; }
        int dev = 0, cus = 0, per_cu = 0;
        hipGetDevice(&dev); hipDeviceGetAttribute(&cus, hipDeviceAttributeMultiprocessorCount, dev);
        hipFuncSetAttribute((const void*)fwd_kernel, hipFuncAttributeMaxDynamicSharedMemorySize, LDS_BYTES);
        hipOccupancyMaxActiveBlocksPerMultiprocessor(&per_cu, (const void*)fwd_kernel, 512, LDS_BYTES);
        if (per_cu < 1) per_cu = 1;
        (void)hipGetLastError();
        grid = cus * per_cu;
    }
    if (grid < 0) return;
    Args a{};
    for (int i = 0; i < 23; ++i) a.in[i] = (const float*)d_in[i];
    a.out = (float*)d_out; a.ws = (unsigned char*)d_ws;
#if MK_PER_PHASE
    for (int ph = 0; ph < NPH; ++ph) { a.ph_lo = ph; a.ph_hi = ph + 1; hipLaunchKernelGGL(fwd_kernel, dim3(grid), dim3(512), LDS_BYTES, stream, a); }
#else
    a.ph_lo = 0; a.ph_hi = NPH;
    void* args[] = {&a};
    hipError_t e = hipLaunchCooperativeKernel((const void*)fwd_kernel, dim3(grid), dim3(512), args, LDS_BYTES, stream);
    if (e != hipSuccess) fprintf(stderr, "cooperative launch failed: %s (grid %d)\n", hipGetErrorString(e), grid);
#endif
}
```
